# Optimizing an MI355X kernel written in HIP

```python
import jax, jax.numpy as jnp
from jax import lax
import numpy as np

D_MODEL = 1024
BATCH = 8
SEQ = 8192
DEPTH = 1

EPS = 1e-6
D_FF = 2816
A_WIDTH = 1024
A_GROUPS = 8
A_GROUP_DIM = A_WIDTH // A_GROUPS
A_CHUNK = 128
B_HEADS = 4
B_KEY_DIM = D_MODEL // 2
B_VAL_DIM = D_MODEL
B_HEAD_K = B_KEY_DIM // B_HEADS
B_HEAD_V = B_VAL_DIM // B_HEADS
B_GATE_RANK = 16
B_GATE_TAU = 16.0
B_CHUNK = 64
IN_SIZES = (A_WIDTH, A_WIDTH,
            B_KEY_DIM, B_KEY_DIM,
            B_VAL_DIM, B_VAL_DIM,
            B_GATE_RANK,
            2 * D_MODEL)
D_IN = sum(IN_SIZES)

kernel_name = "hybrid_gmlp_gla_macaron_block"


def _rmsnorm(x, g):
    xf = x.astype(jnp.float32)
    y = xf * lax.rsqrt(jnp.mean(xf * xf, axis=-1, keepdims=True) + EPS)
    return (y * g.astype(jnp.float32)).astype(x.dtype)


def _layernorm(x, g, b):
    xf = x.astype(jnp.float32)
    mu = jnp.mean(xf, axis=-1, keepdims=True)
    var = jnp.mean(jnp.square(xf - mu), axis=-1, keepdims=True)
    y = (xf - mu) * lax.rsqrt(var + EPS)
    return (y * g.astype(jnp.float32) + b.astype(jnp.float32)).astype(x.dtype)


def _swiglu(x, w_in, w_out):
    a, b = jnp.split(x @ w_in, 2, axis=-1)
    return (jax.nn.silu(a) * b) @ w_out


def _split(z, sizes):
    idx = [int(i) for i in np.cumsum(sizes)[:-1]]
    return jnp.split(z, idx, axis=-1)


def _gmlp_mixer(u, v, ln_g, ln_b, w_s, b_s):
    bsz, s, _ = u.shape
    u = jax.nn.gelu(u, approximate=False)
    v = _layernorm(jax.nn.gelu(v, approximate=False), ln_g, ln_b)
    v = v.reshape(bsz, s // A_CHUNK, A_CHUNK, A_GROUPS, A_GROUP_DIM)
    mask = jnp.tril(jnp.ones((A_CHUNK, A_CHUNK), dtype=bool))
    ws = jnp.where(mask[None], w_s, jnp.zeros_like(w_s))
    sp = jnp.einsum('gij,bnjgc->bnigc', ws, v) + b_s.T[None, None, :, :, None]
    return u * sp.reshape(bsz, s, A_WIDTH)


def _gla_mixer(q, k, v, r, a_lr, w_alpha, b_alpha, head_g):
    bsz, s, _ = q.shape
    n = s // B_CHUNK
    f32 = jnp.float32
    log_a = jax.nn.log_sigmoid((a_lr @ w_alpha + b_alpha).astype(f32)) / B_GATE_TAU

    def heads(t, d):
        return t.astype(f32).reshape(bsz, n, B_CHUNK, B_HEADS, d).transpose(0, 3, 1, 2, 4)

    qh = heads(q, B_HEAD_K) * (B_HEAD_K ** -0.5)
    kh = heads(k, B_HEAD_K)
    vh = heads(v, B_HEAD_V)
    bcum = jnp.cumsum(heads(log_a, B_HEAD_K), axis=3)
    b_mid = bcum[:, :, :, B_CHUNK // 2 - 1:B_CHUNK // 2, :]
    b_last = bcum[:, :, :, -1, :]

    q_in = qh * jnp.exp(bcum - b_mid)
    k_in = kh * jnp.exp(b_mid - bcum)
    scores = jnp.einsum('bhnik,bhnjk->bhnij', q_in, k_in)
    cmask = jnp.tril(jnp.ones((B_CHUNK, B_CHUNK), dtype=bool))
    scores = jnp.where(cmask, scores, 0.0)
    o_intra = jnp.einsum('bhnij,bhnjv->bhniv', scores, vh)

    q_out = qh * jnp.exp(bcum)
    k_st = kh * jnp.exp(b_last[:, :, :, None, :] - bcum)
    decay = jnp.exp(b_last)

    def step(state, xs):
        qn, kn, vn, dn = xs
        o = jnp.einsum('bhik,bhkv->bhiv', qn, state)
        state = dn[..., None] * state + jnp.einsum('bhjk,bhjv->bhkv', kn, vn)
        return state, o

    s0 = jnp.zeros((bsz, B_HEADS, B_HEAD_K, B_HEAD_V), f32)
    xs = (jnp.moveaxis(q_out, 2, 0), jnp.moveaxis(k_st, 2, 0),
          jnp.moveaxis(vh, 2, 0), jnp.moveaxis(decay, 2, 0))
    _, o_inter = lax.scan(step, s0, xs)
    o = o_intra + jnp.moveaxis(o_inter, 0, 2)
    o = o.transpose(0, 2, 3, 1, 4).reshape(bsz, s, B_HEADS, B_HEAD_V)
    o = o * lax.rsqrt(jnp.mean(o * o, axis=-1, keepdims=True) + EPS) * head_g.astype(f32)
    o = o.reshape(bsz, s, B_VAL_DIM).astype(v.dtype)
    return o * jax.nn.silu(r)


def setup_inputs(seed: int = 0) -> dict:
    key = jax.random.key(seed)
    ks = iter(jax.random.split(key, 32))
    L = DEPTH

    def w(shape, fan_in):
        return jax.random.normal(next(ks), shape, jnp.float32) * fan_in ** -0.5

    def gain(shape):
        return 1.0 + 0.1 * jax.random.normal(next(ks), shape, jnp.float32)

    def small(shape, scale):
        return scale * jax.random.normal(next(ks), shape, jnp.float32)

    return {
        "x": jax.random.normal(next(ks), (BATCH, SEQ, D_MODEL), jnp.float32),
        "ffn1_norm": gain((L, D_MODEL)),
        "ffn1_w_in": w((L, D_MODEL, 2 * D_FF), D_MODEL),
        "ffn1_w_out": w((L, D_FF, D_MODEL), D_FF),
        "mix_norm": gain((L, D_MODEL)),
        "w_in": w((L, D_MODEL, D_IN), D_MODEL),
        "b_gate": small((L, 2 * D_MODEL), 0.1),
        "a_ln_gain": gain((L, A_WIDTH)),
        "a_ln_bias": small((L, A_WIDTH), 0.02),
        "a_w_s": w((L, A_GROUPS, A_CHUNK, A_CHUNK), A_CHUNK),
        "a_b_s": gain((L, A_GROUPS, A_CHUNK)),
        "b_w_alpha": w((L, B_GATE_RANK, B_KEY_DIM), B_GATE_RANK),
        "b_b_alpha": small((L, B_KEY_DIM), 0.5),
        "b_head_norm": gain((L, B_HEADS, B_HEAD_V)),
        "w_proj_a": w((L, A_WIDTH, D_MODEL), A_WIDTH),
        "w_proj_b": w((L, B_VAL_DIM, D_MODEL), B_VAL_DIM),
        "w_o": w((L, D_MODEL, D_MODEL), D_MODEL),
        "ffn2_norm": gain((L, D_MODEL)),
        "ffn2_w_in": w((L, D_MODEL, 2 * D_FF), D_MODEL),
        "ffn2_w_out": w((L, D_FF, D_MODEL), D_FF),
        "final_norm": gain((D_MODEL,)),
    }


def reference(x, ffn1_norm, ffn1_w_in, ffn1_w_out, mix_norm, w_in, b_gate,
              a_ln_gain, a_ln_bias, a_w_s, a_b_s, b_w_alpha, b_b_alpha, b_head_norm,
              w_proj_a, w_proj_b, w_o, ffn2_norm, ffn2_w_in, ffn2_w_out, final_norm):
    for l in range(DEPTH):
        x = x + 0.5 * _swiglu(_rmsnorm(x, ffn1_norm[l]), ffn1_w_in[l], ffn1_w_out[l])

        h = _rmsnorm(x, mix_norm[l])
        z = h @ w_in[l]
        u_a, v_a, q_b, k_b, v_b, r_b, alr_b, g = _split(z, IN_SIZES)
        gate_a, gate_b = jnp.split(jax.nn.sigmoid(g + b_gate[l]), 2, axis=-1)

        y_a = _gmlp_mixer(u_a, v_a, a_ln_gain[l], a_ln_bias[l], a_w_s[l], a_b_s[l]) @ w_proj_a[l]
        y_b = _gla_mixer(q_b, k_b, v_b, r_b, alr_b, b_w_alpha[l], b_b_alpha[l],
                         b_head_norm[l]) @ w_proj_b[l]
        x = x + (gate_a * y_a + gate_b * y_b) @ w_o[l]

        x = x + 0.5 * _swiglu(_rmsnorm(x, ffn2_norm[l]), ffn2_w_in[l], ffn2_w_out[l])
    return _rmsnorm(x, final_norm)
```

```cpp
#include <hip/hip_runtime.h>
#include <hip/hip_cooperative_groups.h>
#include <cstdio>
#include <cstdint>
namespace cg = cooperative_groups;

#define LAS __attribute__((address_space(3)))
typedef unsigned short bf16_t;
typedef short bf16x8 __attribute__((ext_vector_type(8)));
typedef float f32x4 __attribute__((ext_vector_type(4)));
typedef float f32x2 __attribute__((ext_vector_type(2)));
typedef unsigned u32x4 __attribute__((ext_vector_type(4)));
typedef unsigned u32x2 __attribute__((ext_vector_type(2)));

constexpr int T = 65536, D = 1024, DFF = 2816, SEQ = 8192;
constexpr int NWIN = 7680;
constexpr float EPS = 1e-6f;
constexpr int NTHREADS = 512;
constexpr int LDS_BYTES = 147456;

constexpr size_t MiB = (size_t)1 << 20;
constexpr size_t WS_RS0 = 1 * MiB;
constexpr size_t WS_SSQ1 = 2 * MiB;
constexpr size_t WS_SSQ2 = 6 * MiB;
constexpr size_t WS_LNST = 10 * MiB;
constexpr size_t WS_W1IN = 20 * MiB, WS_W1OUT = 31 * MiB, WS_WIN = 37 * MiB, WS_WPA = 52 * MiB, WS_WPB = 54 * MiB, WS_WO = 56 * MiB, WS_W2IN = 58 * MiB, WS_W2OUT = 69 * MiB;
constexpr size_t ACT0 = 76 * MiB;
constexpr size_t WS_XB = ACT0;
constexpr size_t WS_H = ACT0 + 128 * MiB;
constexpr size_t WS_U = ACT0 + 128 * MiB;
constexpr size_t WS_V = ACT0 + 256 * MiB;
constexpr size_t WS_Q = ACT0 + 384 * MiB;
constexpr size_t WS_K = ACT0 + 448 * MiB;
constexpr size_t WS_VB = ACT0 + 512 * MiB;
constexpr size_t WS_R = ACT0 + 640 * MiB;
constexpr size_t WS_LA = ACT0 + 768 * MiB;
constexpr size_t WS_X2 = ACT0 + 640 * MiB;
constexpr size_t WS_X2B = ACT0 + 128 * MiB;
constexpr size_t WS_H2 = ACT0 + 256 * MiB;
constexpr size_t WS_END = ACT0 + 896 * MiB;
static_assert(WS_END <= 1024 * MiB, "ws map");

__device__ __forceinline__ unsigned f2bf(float f) { unsigned u = __builtin_bit_cast(unsigned, f); return (u + 0x7fffu + ((u >> 16) & 1u)) >> 16; }
__device__ __forceinline__ unsigned pk2(float lo, float hi) { return f2bf(lo) | (f2bf(hi) << 16); }
__device__ __forceinline__ float bf2f(unsigned short b) { return __builtin_bit_cast(float, ((unsigned)b) << 16); }
__device__ __forceinline__ float bflo(unsigned w) { return __builtin_bit_cast(float, w << 16); }
__device__ __forceinline__ float bfhi(unsigned w) { return __builtin_bit_cast(float, w & 0xffff0000u); }
__device__ __forceinline__ float wave_sum(float v) {
#pragma unroll
    for (int o = 1; o < 64; o <<= 1) v += __shfl_xor(v, o);
    return v;
}

namespace pg8 {
constexpr int BM = 256, BK = 64, HALF = 128, HTB = HALF * BK * 2, STAGE_BYTES = 8 * HTB, NXCD = 8, WGM = 8;
__host__ __device__ __forceinline__ int lds_byte(int r, int c) { const int st = (r >> 4) * 2 + (c >> 5), rr = r & 15, cc = c & 31, ob = rr * 64 + cc * 2; return st * 1024 + (ob ^ (((ob >> 9) & 1) << 5)); }
__host__ __device__ __forceinline__ void stage_rc(int b, int& R, int& C) { const int st = b / 1024, sb = b % 1024, swz = sb ^ (((sb >> 9) & 1) << 5); R = (st >> 1) * 16 + swz / 64; C = (st & 1) * 32 + (swz % 64) / 2; }
__host__ __device__ __forceinline__ int perm32(int rho) { const int n = rho >> 4, i = rho & 15; return 8 * (i >> 2) + 4 * n + (i & 3); }

struct Unit { int pm, pn, seg; };
struct Gemm { const bf16_t *A0, *A1, *B0, *B1; int lda, ldb, K, nsh; };
__device__ __forceinline__ const char* a_ptr(const Gemm& g, const Unit& u) { const bool s = u.seg >= g.nsh; const bf16_t* b = s ? g.A1 : g.A0; const int ks = s ? u.seg - g.nsh : u.seg; return (const char*)(b + (size_t)u.pm * BM * g.lda + ks * g.K); }
__device__ __forceinline__ const char* b_ptr(const Gemm& g, const Unit& u) { const bool s = u.seg >= g.nsh; const bf16_t* b = s ? g.B1 : g.B0; const int ks = s ? u.seg - g.nsh : u.seg; return (const char*)(b + (size_t)u.pn * BM * g.ldb + ks * g.K); }

struct Order {
    int nM, nN, nwg, G, c, nseg;
    __device__ void init(int M, int N, int G_, int c_, int nseg_) { nM = M / BM; nN = N / BM; nwg = nM * nN; G = G_; c = c_; nseg = nseg_; }
    __device__ bool next(int i, Unit& u) const {
        const int ti = i / nseg; u.seg = i - ti * nseg;
        const long L = (long)ti * G + c; if (L >= nwg) return false;
        int wgid = (int)L; { const int q = nwg / NXCD, r = nwg % NXCD, xcd = wgid % NXCD, off = wgid / NXCD; wgid = (xcd < r ? xcd * (q + 1) : r * (q + 1) + (xcd - r) * q) + off; }
        const int nig = WGM * nN, gid = wgid / nig, fm = gid * WGM, gsz = (nM - fm) < WGM ? (nM - fm) : WGM;
        u.pm = fm + ((wgid % nig) % gsz); u.pn = (wgid % nig) / gsz; return true;
    }
};

__device__ __forceinline__ unsigned cvt_pk_bf16(float lo, float hi) { unsigned r; asm volatile("v_cvt_pk_bf16_f32 %0, %1, %2" : "=v"(r) : "v"(lo), "v"(hi)); return r; }
__device__ __forceinline__ f32x2 gelu_pk(f32x2 v) {
    const f32x2 av = __builtin_elementwise_abs(v), d = av * 0.2316418882f + 1.0f;
    f32x2 t; t.x = __builtin_amdgcn_rcpf(d.x); t.y = __builtin_amdgcn_rcpf(d.y);
    f32x2 q = t * 0.5307027145f + (-0.7265760135f); q = q * t + 0.7107068705f; q = q * t + (-0.142248368f); q = q * t + 0.127414796f; q = q * t;
    const f32x2 s = (v * v) * (-0.72134752044f);
    f32x2 e; e.x = __builtin_amdgcn_exp2f(s.x); e.y = __builtin_amdgcn_exp2f(s.y);
    const f32x2 m = v * (q * e), r = v - m;
    f32x2 o; o.x = v.x < 0.f ? m.x : r.x; o.y = v.y < 0.f ? m.y : r.y; return o;
}
__device__ __forceinline__ f32x4 gelu4(f32x4 v) { const f32x2 a = gelu_pk((f32x2){v[0], v[1]}), b = gelu_pk((f32x2){v[2], v[3]}); return (f32x4){a.x, a.y, b.x, b.y}; }
__device__ __forceinline__ float sigm(float x) { return __builtin_amdgcn_rcpf(1.0f + __expf(-x)); }
__device__ __forceinline__ f32x4 sigm4(f32x4 v) { return (f32x4){sigm(v[0]), sigm(v[1]), sigm(v[2]), sigm(v[3])}; }
__device__ __forceinline__ f32x4 silu4(f32x4 v) { return v * sigm4(v); }
__device__ __forceinline__ float lsig16(float x) { return (fminf(x, 0.f) - log1pf(__expf(-fabsf(x)))) * 0.0625f; }
__device__ __forceinline__ f32x4 lsig4(f32x4 v) { return (f32x4){lsig16(v[0]), lsig16(v[1]), lsig16(v[2]), lsig16(v[3])}; }
__device__ __forceinline__ u32x4 pack8(f32x4 v0, f32x4 v1) { u32x4 w; w.x = cvt_pk_bf16(v0[0], v0[1]); w.y = cvt_pk_bf16(v0[2], v0[3]); w.z = cvt_pk_bf16(v1[0], v1[1]); w.w = cvt_pk_bf16(v1[2], v1[3]); return w; }
__device__ __forceinline__ void unpack8(u32x4 w, f32x4& v0, f32x4& v1) { v0 = (f32x4){bflo(w.x), bfhi(w.x), bflo(w.y), bfhi(w.y)}; v1 = (f32x4){bflo(w.z), bfhi(w.z), bflo(w.w), bfhi(w.w)}; }
__device__ __forceinline__ float row_rs16(const float* ssq, int row, int fq) {
    const f32x4 v = *(const f32x4*)(ssq + (size_t)row * 16 + 4 * fq); float s = (v[0] + v[1]) + (v[2] + v[3]);
    s += __shfl_xor(s, 16); s += __shfl_xor(s, 32);
    return 1.0f / sqrtf(s * (1.0f / 1024.0f) + EPS);
}

typedef f32x4 Acc[2][2][4][2];

struct EpiSwiGLU {
    const float* rs_direct;
    const float* ssq;
    bf16_t* H;
    __device__ __forceinline__ bool keep(const Unit&) const { return false; }
    __device__ __forceinline__ void operator()(Acc& acc, const Unit& u, int wr, int wc, int fr, int fq) const {
        const int row0 = u.pm * BM + wr * 64 + fr, col0 = u.pn * 128 + wc * 32 + 8 * fq;
        float rsv[2][4];
#pragma unroll
        for (int ai = 0; ai < 2; ++ai)
#pragma unroll
            for (int m = 0; m < 4; ++m) { const int row = row0 + ai * HALF + m * 16; rsv[ai][m] = rs_direct ? rs_direct[row] : row_rs16(ssq, row, fq); }
#pragma unroll
        for (int ai = 0; ai < 2; ++ai)
#pragma unroll
            for (int m = 0; m < 4; ++m) { const int row = row0 + ai * HALF + m * 16;
                const float rs = rsv[ai][m];
                const f32x4 a0 = acc[ai][0][m][0] * rs, a1 = acc[ai][0][m][1] * rs, b0 = acc[ai][1][m][0] * rs, b1 = acc[ai][1][m][1] * rs;
                *(u32x4*)(H + (size_t)row * DFF + col0) = pack8(silu4(a0) * b0, silu4(a1) * b1); }
    }
};
template <bool BASE_BF16, bool OUT_F32, bool OUT_BF16> struct EpiResid {
    const void* base; float scale; float* of32; bf16_t* obf; float* ssq;
    __device__ __forceinline__ bool keep(const Unit&) const { return false; }
    __device__ __forceinline__ void operator()(Acc& acc, const Unit& u, int wr, int wc, int fr, int fq) const {
        const int row0 = u.pm * BM + wr * 64 + fr, col0 = u.pn * BM + wc * 32 + 8 * fq;
#pragma unroll
        for (int ai = 0; ai < 2; ++ai)
#pragma unroll
            for (int m = 0; m < 4; ++m) { const int row = row0 + ai * HALF + m * 16; const size_t off = (size_t)row * D + col0; float q = 0.f;
#pragma unroll
                for (int bj = 0; bj < 2; ++bj) { f32x4 b0, b1;
                    if (BASE_BF16) unpack8(*(const u32x4*)((const bf16_t*)base + off + bj * HALF), b0, b1);
                    else { b0 = *(const f32x4*)((const float*)base + off + bj * HALF); b1 = *(const f32x4*)((const float*)base + off + bj * HALF + 4); }
                    const f32x4 v0 = b0 + acc[ai][bj][m][0] * scale, v1 = b1 + acc[ai][bj][m][1] * scale;
                    q += (v0[0] * v0[0] + v0[1] * v0[1]) + (v0[2] * v0[2] + v0[3] * v0[3]) + (v1[0] * v1[0] + v1[1] * v1[1]) + (v1[2] * v1[2] + v1[3] * v1[3]);
                    if (OUT_F32) { *(f32x4*)(of32 + off + bj * HALF) = v0; *(f32x4*)(of32 + off + bj * HALF + 4) = v1; }
                    if (OUT_BF16) *(u32x4*)(obf + off + bj * HALF) = pack8(v0, v1); }
                q += __shfl_xor(q, 16); q += __shfl_xor(q, 32);
                if (ssq && fq == 0) ssq[(size_t)row * 16 + 4 * u.pn + wc] = q; }
    }
};
struct EpiWin {
    const float* ssq; bf16_t *U, *V, *Q, *Kb, *VB, *R, *G, *LA; float* lnst; const float *b_gate, *b_alpha;
    __device__ __forceinline__ bool keep(const Unit&) const { return false; }
    __device__ __forceinline__ void operator()(Acc& acc, const Unit& u, int wr, int wc, int fr, int fq) const {
        const int pn = u.pn; int kind, ld, colt; bf16_t* basep; const float* bias = nullptr; float sc = 1.f; bool stats = false;
        if (pn < 4) { kind = 1; basep = U; ld = 1024; colt = 256 * pn; }
        else if (pn < 8) { kind = 1; basep = V; ld = 1024; colt = 256 * (pn - 4); stats = true; }
        else if (pn < 10) { kind = 0; basep = Q; ld = 512; colt = 256 * (pn - 8); sc = 0.08838834764831845f; }
        else if (pn < 12) { kind = 0; basep = Kb; ld = 512; colt = 256 * (pn - 10); }
        else if (pn < 16) { kind = 0; basep = VB; ld = 1024; colt = 256 * (pn - 12); }
        else if (pn < 20) { kind = 2; basep = R; ld = 1024; colt = 256 * (pn - 16); }
        else if (pn < 28) { kind = 3; basep = G; ld = 2048; colt = 256 * (pn - 20); bias = b_gate; }
        else { kind = 4; basep = LA; ld = 512; colt = 256 * (pn - 28); bias = b_alpha; }
        const int row0 = u.pm * BM + wr * 64 + fr, col0 = colt + wc * 32 + 8 * fq;
        f32x4 bv[2][2];
#pragma unroll
        for (int bj = 0; bj < 2; ++bj)
#pragma unroll
            for (int n = 0; n < 2; ++n) bv[bj][n] = bias ? *(const f32x4*)(bias + col0 + bj * HALF + 4 * n) : (f32x4){0.f, 0.f, 0.f, 0.f};
        float rsv[2][4];
#pragma unroll
        for (int ai = 0; ai < 2; ++ai)
#pragma unroll
            for (int m = 0; m < 4; ++m) rsv[ai][m] = row_rs16(ssq, row0 + ai * HALF + m * 16, fq) * sc;
#pragma unroll
        for (int ai = 0; ai < 2; ++ai)
#pragma unroll
            for (int m = 0; m < 4; ++m) { const int row = row0 + ai * HALF + m * 16; const float rs = rsv[ai][m]; float s1 = 0.f, s2 = 0.f;
                bf16_t* rowp = basep + (size_t)row * ld + col0;
#pragma unroll
                for (int bj = 0; bj < 2; ++bj) { f32x4 v0 = acc[ai][bj][m][0] * rs + bv[bj][0], v1 = acc[ai][bj][m][1] * rs + bv[bj][1];
                    if (kind == 1) { v0 = gelu4(v0); v1 = gelu4(v1); }
                    else if (kind == 2) { v0 = silu4(v0); v1 = silu4(v1); }
                    else if (kind == 3) { v0 = sigm4(v0); v1 = sigm4(v1); }
                    else if (kind == 4) { v0 = lsig4(v0); v1 = lsig4(v1); }
                    s1 += (v0[0] + v0[1]) + (v0[2] + v0[3]) + (v1[0] + v1[1]) + (v1[2] + v1[3]);
                    s2 += (v0[0] * v0[0] + v0[1] * v0[1]) + (v0[2] * v0[2] + v0[3] * v0[3]) + (v1[0] * v1[0] + v1[1] * v1[1]) + (v1[2] * v1[2] + v1[3] * v1[3]);
                    *(u32x4*)(rowp + bj * HALF) = pack8(v0, v1); }
                if (stats) { s1 += __shfl_xor(s1, 16); s1 += __shfl_xor(s1, 32); s2 += __shfl_xor(s2, 16); s2 += __shfl_xor(s2, 32);
                    if (fq == 0) *(f32x2*)(lnst + ((size_t)row * 16 + 4 * (pn - 4) + wc) * 2) = (f32x2){s1, s2}; } }
    }
};
struct EpiProj {
    const bf16_t* G; bf16_t* Mb;
    __device__ __forceinline__ bool keep(const Unit& u) const { return u.seg == 0; }
    __device__ __forceinline__ void operator()(Acc& acc, const Unit& u, int wr, int wc, int fr, int fq) const {
        const int row0 = u.pm * BM + wr * 64 + fr, col0 = u.pn * BM + wc * 32 + 8 * fq;
#pragma unroll
        for (int ai = 0; ai < 2; ++ai)
#pragma unroll
            for (int m = 0; m < 4; ++m) { const int row = row0 + ai * HALF + m * 16;
#pragma unroll
                for (int bj = 0; bj < 2; ++bj) { const bf16_t* gp = G + (size_t)row * 2048 + col0 + bj * HALF;
                    f32x4 sb0, sb1; unpack8(*(const u32x4*)(gp + 1024), sb0, sb1);
                    if (u.seg == 0) { f32x4 sa0, sa1; unpack8(*(const u32x4*)gp, sa0, sa1);
#pragma unroll
                        for (int e = 0; e < 4; ++e) { acc[ai][bj][m][0][e] *= sa0[e] * __builtin_amdgcn_rcpf(fmaxf(sb0[e], 1e-30f)); acc[ai][bj][m][1][e] *= sa1[e] * __builtin_amdgcn_rcpf(fmaxf(sb1[e], 1e-30f)); } }
                    else *(u32x4*)(Mb + (size_t)row * D + col0 + bj * HALF) = pack8(acc[ai][bj][m][0] * sb0, acc[ai][bj][m][1] * sb1); } }
    }
};

template <class Epi>
__device__ __forceinline__ void gemm_phase(LAS unsigned char* lds, const Gemm g, const Order& S, const Epi& E) {
    const int tid = threadIdx.x, wid = __builtin_amdgcn_readfirstlane(tid >> 6), lane = tid & 63, wr = wid >> 2, wc = wid & 3, fr = lane & 15, fq = lane >> 4;
    const int nt = g.K / BK;
    unsigned voffA[2], voffB[2];
#pragma unroll
    for (int i = 0; i < 2; ++i) { int R, C; stage_rc(tid * 16 + i * 8192, R, C); const int Rb = (R & ~31) + perm32(R & 31);
        voffA[i] = (unsigned)(R * g.lda + C) * 2u; voffB[i] = (unsigned)(Rb * g.ldb + C) * 2u; }
    const size_t kstep = (size_t)(BK * 2);
    const size_t hstepA = (size_t)HALF * g.lda * 2, hstepB = (size_t)HALF * g.ldb * 2;
    const unsigned ldsw = (unsigned)wid * 1024u;
    const int aoff = lds_byte(wr * 64 + fr, fq * 8), boff = lds_byte(wc * 32 + fr, fq * 8);
#define PG8_SA(b, h) (((b) * 2 + (h)) * HTB)
#define PG8_SB(b, h) ((4 + (b) * 2 + (h)) * HTB)
#define PG8_STAGE(bufoff, gbase, voff) do { _Pragma("unroll") for (int _i = 0; _i < 2; ++_i) \
        __builtin_amdgcn_global_load_lds((const unsigned*)((const char*)(gbase) + (voff)[_i]), (LAS unsigned*)(lds + (bufoff) + ldsw + _i * 8192), 16, 0, 0); } while (0)
#define PG8_LDA(dst, b, h) do { _Pragma("unroll") for (int m = 0; m < 4; ++m) _Pragma("unroll") for (int k = 0; k < 2; ++k) dst[m][k] = *(const LAS bf16x8*)(lds + PG8_SA(b, h) + aoff + m * 2048 + k * 1024); } while (0)
#define PG8_LDB(dst, b, h) do { _Pragma("unroll") for (int n = 0; n < 2; ++n) _Pragma("unroll") for (int k = 0; k < 2; ++k) dst[n][k] = *(const LAS bf16x8*)(lds + PG8_SB(b, h) + boff + n * 2048 + k * 1024); } while (0)
#define PG8_MMA(ai, bj, At, Bt) do { __builtin_amdgcn_s_setprio(1); _Pragma("unroll") for (int m = 0; m < 4; ++m) _Pragma("unroll") for (int n = 0; n < 2; ++n) _Pragma("unroll") for (int k = 0; k < 2; ++k) \
        acc[ai][bj][m][n] = __builtin_amdgcn_mfma_f32_16x16x32_bf16(Bt[n][k], At[m][k], acc[ai][bj][m][n], 0, 0, 0); __builtin_amdgcn_s_setprio(0); } while (0)
#define PG8_WAIT_V(n) asm volatile("s_waitcnt vmcnt(" #n ")" ::: "memory")
#define PG8_WAIT_L(n) asm volatile("s_waitcnt lgkmcnt(" #n ")" ::: "memory")
#define PG8_BAR __builtin_amdgcn_s_barrier()
#define PG8_SCHED __builtin_amdgcn_sched_barrier(0)
    Unit cur, nxt; int ui = 0;
    if (!S.next(0, cur)) return;
    Acc acc;
#pragma unroll
    for (int a = 0; a < 2; ++a)
#pragma unroll
        for (int b = 0; b < 2; ++b)
#pragma unroll
            for (int m = 0; m < 4; ++m)
#pragma unroll
                for (int n = 0; n < 2; ++n) acc[a][b][m][n] = (f32x4){0.f, 0.f, 0.f, 0.f};
    bf16x8 At[4][2], B0[2][2], B1[2][2];
    const char* cA = a_ptr(g, cur); const char* cB = b_ptr(g, cur);
    PG8_STAGE(PG8_SB(0, 0), cB, voffB); PG8_STAGE(PG8_SB(0, 1), cB + hstepB, voffB); PG8_STAGE(PG8_SA(0, 0), cA, voffA); PG8_STAGE(PG8_SA(0, 1), cA + hstepA, voffA);
    if (wr == 1) PG8_BAR;
    PG8_WAIT_V(2); PG8_BAR;
    PG8_STAGE(PG8_SB(1, 0), cB + kstep, voffB); PG8_STAGE(PG8_SA(1, 0), cA + kstep, voffA); PG8_STAGE(PG8_SB(1, 1), cB + hstepB + kstep, voffB);
    PG8_WAIT_V(6); PG8_BAR;
    for (;;) {
        const bool has_next = S.next(ui + 1, nxt);
        const char* nA = has_next ? a_ptr(g, nxt) : cA; const char* nB = has_next ? b_ptr(g, nxt) : cB;
        for (int t = 0; t < nt; t += 2) {
            const bool last = (t == nt - 2);
            const char* a1 = cA + (size_t)(t + 1) * kstep;
            const char* a2 = last ? nA : cA + (size_t)(t + 2) * kstep; const char* b2 = last ? nB : cB + (size_t)(t + 2) * kstep;
            const char* a3 = a2 + kstep; const char* b3 = b2 + kstep;
            PG8_LDB(B0, 0, 0); PG8_LDB(B1, 0, 1); PG8_SCHED; PG8_LDA(At, 0, 0); PG8_STAGE(PG8_SA(1, 1), a1 + hstepA, voffA);
            PG8_WAIT_V(8); PG8_WAIT_L(0); PG8_BAR; PG8_MMA(0, 0, At, B0); PG8_MMA(0, 1, At, B1); PG8_BAR; PG8_SCHED;
            PG8_LDA(At, 0, 1); PG8_STAGE(PG8_SB(0, 0), b2, voffB); PG8_STAGE(PG8_SB(0, 1), b2 + hstepB, voffB); PG8_STAGE(PG8_SA(0, 0), a2, voffA);
            PG8_WAIT_V(8); PG8_WAIT_L(0); PG8_BAR; PG8_MMA(1, 0, At, B0); PG8_MMA(1, 1, At, B1); PG8_BAR; PG8_SCHED;
            PG8_LDB(B0, 1, 0); PG8_LDB(B1, 1, 1); PG8_SCHED; PG8_LDA(At, 1, 0); PG8_STAGE(PG8_SA(0, 1), a2 + hstepA, voffA);
            PG8_WAIT_V(8); PG8_WAIT_L(0); PG8_BAR; PG8_MMA(0, 0, At, B0); PG8_MMA(0, 1, At, B1); PG8_BAR; PG8_SCHED;
            PG8_LDA(At, 1, 1); PG8_STAGE(PG8_SB(1, 0), b3, voffB); PG8_STAGE(PG8_SB(1, 1), b3 + hstepB, voffB); PG8_STAGE(PG8_SA(1, 0), a3, voffA);
            PG8_WAIT_V(8); PG8_WAIT_L(0); PG8_BAR; PG8_MMA(1, 0, At, B0); PG8_MMA(1, 1, At, B1); PG8_BAR; PG8_SCHED;
        }
        if (wr == 0) PG8_BAR;
        E(acc, cur, wr, wc, fr, fq);
        if (!has_next) break;
        if (!E.keep(cur)) {
#pragma unroll
            for (int a = 0; a < 2; ++a)
#pragma unroll
                for (int b = 0; b < 2; ++b)
#pragma unroll
                    for (int m = 0; m < 4; ++m)
#pragma unroll
                        for (int n = 0; n < 2; ++n) acc[a][b][m][n] = (f32x4){0.f, 0.f, 0.f, 0.f};
        }
        cur = nxt; cA = nA; cB = nB; ++ui;
        if (wr == 1) PG8_BAR;
    }
    PG8_WAIT_V(0);
    PG8_BAR;
#undef PG8_SA
#undef PG8_SB
#undef PG8_STAGE
#undef PG8_LDA
#undef PG8_LDB
#undef PG8_MMA
#undef PG8_WAIT_V
#undef PG8_WAIT_L
#undef PG8_BAR
#undef PG8_SCHED
}
}

struct Params {
    const float* in[21];
    float* out;
    unsigned char* ws;
    int ph_lo, ph_hi;
};
enum { I_X = 0, I_F1N, I_F1WI, I_F1WO, I_MIXN, I_WIN, I_BGATE, I_ALNG, I_ALNB, I_AWS, I_ABS, I_BWA, I_BBA, I_BHN, I_WPA, I_WPB, I_WO, I_F2N, I_F2WI, I_F2WO, I_FINN };

__device__ __forceinline__ void transpose_item(const float* W, int ldw, int src_col0, const float* gain, bf16_t* WT, int K, int dst_row0, int k0, LAS float* scr, int lane) {
#pragma unroll 8
    for (int i = 0; i < 32; ++i) { const int kk = 2 * i + (lane >> 5); float v = W[(size_t)(k0 + kk) * ldw + src_col0 + (lane & 31)]; if (gain) v *= gain[k0 + kk]; scr[kk * 33 + (lane & 31)] = v; }
    asm volatile("s_waitcnt lgkmcnt(0)" ::: "memory");
    const int c = lane & 7;
#pragma unroll
    for (int j = 0; j < 4; ++j) { const int n = (lane >> 3) + 8 * j; const LAS float* s = scr + (8 * c) * 33 + n;
        u32x4 o; o.x = pk2(s[0 * 33], s[1 * 33]); o.y = pk2(s[2 * 33], s[3 * 33]); o.z = pk2(s[4 * 33], s[5 * 33]); o.w = pk2(s[6 * 33], s[7 * 33]);
        *(u32x4*)(WT + (size_t)(dst_row0 + n) * K + k0 + 8 * c) = o; }
    asm volatile("s_waitcnt lgkmcnt(0)" ::: "memory");
}
__device__ __forceinline__ void transpose_matrix_item(int it, int kind, const float* W, int ldw, int K, int ndst, const float* gain, bf16_t* WT, LAS float* scr, int lane) {
    const int nblk = ndst / 32, kb = it / nblk, nb = it % nblk, n0 = 32 * nb; int src;
    if (kind == 1) { const int pn = nb >> 3, w = nb & 7; src = (w >> 2) * DFF + 128 * pn + 32 * (w & 3); }
    else if (kind == 2) src = n0 < 5120 ? n0 : n0 + 16;
    else src = n0;
    transpose_item(W, ldw, src, gain, WT, K, n0, 64 * kb, scr, lane);
}
__device__ __forceinline__ void p0_prep(const Params& p, LAS unsigned char* lds) {
    const int tid = threadIdx.x, lane = tid & 63, wave = tid >> 6;
    const int gw = blockIdx.x * 8 + wave, NGW = gridDim.x * 8;
    LAS float* scr = (LAS float*)(lds + wave * 16384);
    unsigned char* ws = p.ws;
    constexpr int I_FI = (D / 64) * (2 * DFF / 32), I_FO = (DFF / 64) * (D / 32), I_WI = (D / 64) * (7168 / 32), I_SQ = (D / 64) * (D / 32);
    constexpr int NITEMS = 2 * I_FI + 2 * I_FO + I_WI + 3 * I_SQ;
    for (int it = gw; it < NITEMS; it += NGW) {
        int r = it;
        if (r < I_FI) { transpose_matrix_item(r, 1, p.in[I_F1WI], 2 * DFF, D, 2 * DFF, p.in[I_F1N], (bf16_t*)(ws + WS_W1IN), scr, lane); continue; } r -= I_FI;
        if (r < I_FI) { transpose_matrix_item(r, 1, p.in[I_F2WI], 2 * DFF, D, 2 * DFF, p.in[I_F2N], (bf16_t*)(ws + WS_W2IN), scr, lane); continue; } r -= I_FI;
        if (r < I_FO) { transpose_matrix_item(r, 0, p.in[I_F1WO], D, DFF, D, nullptr, (bf16_t*)(ws + WS_W1OUT), scr, lane); continue; } r -= I_FO;
        if (r < I_FO) { transpose_matrix_item(r, 0, p.in[I_F2WO], D, DFF, D, nullptr, (bf16_t*)(ws + WS_W2OUT), scr, lane); continue; } r -= I_FO;
        if (r < I_WI) { transpose_matrix_item(r, 2, p.in[I_WIN], 7184, D, 7168, p.in[I_MIXN], (bf16_t*)(ws + WS_WIN), scr, lane); continue; } r -= I_WI;
        if (r < I_SQ) { transpose_matrix_item(r, 0, p.in[I_WPA], D, D, D, nullptr, (bf16_t*)(ws + WS_WPA), scr, lane); continue; } r -= I_SQ;
        if (r < I_SQ) { transpose_matrix_item(r, 0, p.in[I_WPB], D, D, D, nullptr, (bf16_t*)(ws + WS_WPB), scr, lane); continue; } r -= I_SQ;
        transpose_matrix_item(r, 0, p.in[I_WO], D, D, D, nullptr, (bf16_t*)(ws + WS_WO), scr, lane);
    }
    {
        bf16_t* WT = (bf16_t*)(ws + WS_WIN) + (size_t)7168 * D; const float* W = p.in[I_WIN]; const float* wa = p.in[I_BWA]; const float* gn = p.in[I_MIXN];
        for (int idx = blockIdx.x * NTHREADS + tid; idx < 512 * D; idx += gridDim.x * NTHREADS) { const int n = idx >> 10, k = idx & 1023; float s = 0.f;
#pragma unroll
            for (int r = 0; r < 16; ++r) s += W[(size_t)k * 7184 + 5120 + r] * wa[r * 512 + n];
            WT[idx] = (bf16_t)f2bf(s * gn[k]); }
    }
    {
        const float* x = p.in[I_X]; bf16_t* xb = (bf16_t*)(ws + WS_XB); float* rs0 = (float*)(ws + WS_RS0);
        for (int m = gw; m < T; m += NGW) { const f32x4* xr = (const f32x4*)(x + (size_t)m * D) + lane; unsigned long long* o8 = (unsigned long long*)(xb + (size_t)m * D) + lane; float s = 0.f;
#pragma unroll
            for (int j = 0; j < 4; ++j) { const f32x4 v = xr[64 * j]; s += (v[0] * v[0] + v[1] * v[1]) + (v[2] * v[2] + v[3] * v[3]); o8[64 * j] = (unsigned long long)pk2(v[0], v[1]) | ((unsigned long long)pk2(v[2], v[3]) << 32); }
            s = wave_sum(s); if (lane == 0) rs0[m] = 1.0f / sqrtf(s * (1.0f / D) + EPS); }
    }
}

__device__ __forceinline__ void p4_gmlp_simple(const Params& p, LAS unsigned char* lds) {
    const int tid = threadIdx.x;
    unsigned char* ws = p.ws;
    bf16_t* U = (bf16_t*)(ws + WS_U); const bf16_t* V = (const bf16_t*)(ws + WS_V); const float* lnst = (const float*)(ws + WS_LNST);
    const float* lg = p.in[I_ALNG]; const float* lb = p.in[I_ALNB]; const float* Wsg = p.in[I_AWS]; const float* bs = p.in[I_ABS];
    LAS float* Wsm = (LAS float*)lds;
    LAS float* vln = Wsm + 128 * 128;
    LAS float* mu = vln + 128 * 128;
    LAS float* rstd = mu + 128;
    const int g = blockIdx.x & 7;
    for (int e = tid; e < 128 * 128; e += NTHREADS) { const int i = e >> 7, j = e & 127; Wsm[e] = (j <= i) ? Wsg[(size_t)g * 16384 + e] : 0.f; }
    const int c = tid & 127, iq = tid >> 7;
    for (int tile = blockIdx.x; tile < 4096; tile += gridDim.x) {
        const int chunk = tile >> 3; const size_t t0 = (size_t)chunk * 128;
        __syncthreads();
        if (tid < 128) { const float* st = lnst + (t0 + tid) * 32; float s1 = 0.f, s2 = 0.f;
#pragma unroll
            for (int q = 0; q < 16; ++q) { s1 += st[2 * q]; s2 += st[2 * q + 1]; }
            const float mean = s1 * (1.0f / 1024.0f), var = s2 * (1.0f / 1024.0f) - mean * mean; mu[tid] = mean; rstd[tid] = 1.0f / sqrtf(fmaxf(var, 0.f) + EPS); }
        __syncthreads();
        for (int e = tid; e < 128 * 128; e += NTHREADS) { const int j = e >> 7, cc = e & 127; const float v = bf2f(V[(t0 + j) * 1024 + g * 128 + cc]);
            vln[e] = (v - mu[j]) * rstd[j] * lg[g * 128 + cc] + lb[g * 128 + cc]; }
        __syncthreads();
        float acc[32];
#pragma unroll
        for (int ii = 0; ii < 32; ++ii) acc[ii] = 0.f;
        const int jmax = (iq + 1) * 32;
        for (int j = 0; j < jmax; j += 4) {
            const float v0 = vln[(j + 0) * 128 + c], v1 = vln[(j + 1) * 128 + c], v2 = vln[(j + 2) * 128 + c], v3 = vln[(j + 3) * 128 + c];
#pragma unroll
            for (int ii = 0; ii < 32; ++ii) { const f32x4 w = *(const LAS f32x4*)(Wsm + (iq * 32 + ii) * 128 + j); acc[ii] += (w[0] * v0 + w[1] * v1) + (w[2] * v2 + w[3] * v3); }
        }
#pragma unroll
        for (int ii = 0; ii < 32; ++ii) { const int i = iq * 32 + ii; const size_t idx = (t0 + i) * 1024 + g * 128 + c;
            U[idx] = (bf16_t)f2bf(bf2f(U[idx]) * (acc[ii] + bs[g * 128 + i])); }
    }
    __syncthreads();
}

__device__ __forceinline__ void p4_gla_simple(const Params& p, LAS unsigned char* lds) {
    if (blockIdx.x >= 32) return;
    const int tid = threadIdx.x, lane = tid & 63, wave = tid >> 6;
    unsigned char* ws = p.ws;
    const bf16_t* Q = (const bf16_t*)(ws + WS_Q); const bf16_t* Kb = (const bf16_t*)(ws + WS_K); const bf16_t* VB = (const bf16_t*)(ws + WS_VB); const bf16_t* LA = (const bf16_t*)(ws + WS_LA);
    bf16_t* R = (bf16_t*)(ws + WS_R); const float* hg = p.in[I_BHN];
    const int b = blockIdx.x >> 2, h = blockIdx.x & 3, v = tid & 255, kh = tid >> 8;
    LAS float* qs = (LAS float*)lds; LAS float* ks = qs + 2048; LAS float* as = ks + 2048; LAS float* obuf = as + 2048; LAS float* red = obuf + 8192;
    float S[64];
#pragma unroll
    for (int i = 0; i < 64; ++i) S[i] = 0.f;
    const float hgv = hg[h * 256 + v];
    for (int t0 = 0; t0 < SEQ; t0 += 16) {
#pragma unroll
        for (int e = 0; e < 4; ++e) { const int idx = tid + 512 * e, tt = idx >> 7, k = idx & 127; const size_t row = (size_t)b * SEQ + t0 + tt;
            qs[idx] = bf2f(Q[row * 512 + h * 128 + k]); ks[idx] = bf2f(Kb[row * 512 + h * 128 + k]); as[idx] = __expf(bf2f(LA[row * 512 + h * 128 + k])); }
        __syncthreads();
        for (int tt = 0; tt < 16; ++tt) {
            const size_t row = (size_t)b * SEQ + t0 + tt; const float vv = bf2f(VB[row * 1024 + h * 256 + v]); float o = 0.f;
#pragma unroll
            for (int k4 = 0; k4 < 16; ++k4) { const f32x4 a4 = *(const LAS f32x4*)(as + tt * 128 + 64 * kh + 4 * k4), kk4 = *(const LAS f32x4*)(ks + tt * 128 + 64 * kh + 4 * k4), q4 = *(const LAS f32x4*)(qs + tt * 128 + 64 * kh + 4 * k4);
#pragma unroll
                for (int e = 0; e < 4; ++e) { S[4 * k4 + e] = a4[e] * S[4 * k4 + e] + kk4[e] * vv; o += q4[e] * S[4 * k4 + e]; } }
            obuf[(kh * 16 + tt) * 256 + v] = o;
        }
        __syncthreads();
        float oo[8];
#pragma unroll
        for (int j = 0; j < 8; ++j) { const int tt = kh * 8 + j; const float o = obuf[tt * 256 + v] + obuf[(16 + tt) * 256 + v]; oo[j] = o; const float s = wave_sum(o * o); if (lane == 0) red[tt * 4 + (wave & 3)] = s; }
        __syncthreads();
#pragma unroll
        for (int j = 0; j < 8; ++j) { const int tt = kh * 8 + j; const float ss = (red[tt * 4] + red[tt * 4 + 1]) + (red[tt * 4 + 2] + red[tt * 4 + 3]); const float rs = 1.0f / sqrtf(ss * (1.0f / 256.0f) + EPS);
            const size_t idx = ((size_t)b * SEQ + t0 + tt) * 1024 + h * 256 + v; R[idx] = (bf16_t)f2bf(oo[j] * rs * hgv * bf2f(R[idx])); }
        __syncthreads();
    }
}

__device__ __forceinline__ void p9_final(const Params& p) {
    const int tid = threadIdx.x, lane = tid & 63, wave = tid >> 6;
    const int gw = blockIdx.x * 8 + wave, NGW = gridDim.x * 8;
    const f32x4* gr = (const f32x4*)(p.in[I_FINN]) + lane;
    for (int m = gw; m < T; m += NGW) { f32x4* xr = (f32x4*)(p.out + (size_t)m * D) + lane; f32x4 v[4]; float s = 0.f;
#pragma unroll
        for (int j = 0; j < 4; ++j) { v[j] = xr[64 * j]; s += (v[j][0] * v[j][0] + v[j][1] * v[j][1]) + (v[j][2] * v[j][2] + v[j][3] * v[j][3]); }
        const float rs = 1.0f / sqrtf(wave_sum(s) * (1.0f / D) + EPS);
#pragma unroll
        for (int j = 0; j < 4; ++j) xr[64 * j] = v[j] * rs * gr[64 * j]; }
}

__global__ void __launch_bounds__(NTHREADS, 2) mega_fwd(Params p) {
    extern __shared__ __attribute__((aligned(16))) unsigned char lds_raw[];
    LAS unsigned char* lds = (LAS unsigned char*)lds_raw;
    cg::grid_group grid = cg::this_grid();
    unsigned char* ws = p.ws;
    const int G = gridDim.x, c = blockIdx.x;
    const int lo = p.ph_lo, hi = p.ph_hi;
#define IN(k) (lo <= (k) && (k) < hi)
#define SEAM(k) do { if (IN(k) && IN((k) + 1)) grid.sync(); } while (0)
    if (IN(0)) p0_prep(p, lds);
    SEAM(0);
    if (IN(1)) {
        pg8::Gemm g{(const bf16_t*)(ws + WS_XB), nullptr, (const bf16_t*)(ws + WS_W1IN), nullptr, D, D, D, 1}; pg8::Order S; S.init(T, 2 * DFF, G, c, 1);
        pg8::EpiSwiGLU E{(const float*)(ws + WS_RS0), nullptr, (bf16_t*)(ws + WS_H)};
        pg8::gemm_phase(lds, g, S, E);
    }
    SEAM(1);
    if (IN(2)) {
        pg8::Gemm g{(const bf16_t*)(ws + WS_H), nullptr, (const bf16_t*)(ws + WS_W1OUT), nullptr, DFF, DFF, DFF, 1}; pg8::Order S; S.init(T, D, G, c, 1);
        pg8::EpiResid<false, false, true> E{p.in[I_X], 0.5f, nullptr, (bf16_t*)(ws + WS_XB), (float*)(ws + WS_SSQ1)};
        pg8::gemm_phase(lds, g, S, E);
    }
    SEAM(2);
    if (IN(3)) {
        pg8::Gemm g{(const bf16_t*)(ws + WS_XB), nullptr, (const bf16_t*)(ws + WS_WIN), nullptr, D, D, D, 1}; pg8::Order S; S.init(T, NWIN, G, c, 1);
        pg8::EpiWin E{(const float*)(ws + WS_SSQ1), (bf16_t*)(ws + WS_U), (bf16_t*)(ws + WS_V), (bf16_t*)(ws + WS_Q), (bf16_t*)(ws + WS_K), (bf16_t*)(ws + WS_VB), (bf16_t*)(ws + WS_R), (bf16_t*)p.out, (bf16_t*)(ws + WS_LA),
                      (float*)(ws + WS_LNST), p.in[I_BGATE], p.in[I_BBA]};
        pg8::gemm_phase(lds, g, S, E);
    }
    SEAM(3);
    if (IN(4)) { p4_gla_simple(p, lds); __syncthreads(); p4_gmlp_simple(p, lds); }
    SEAM(4);
    if (IN(5)) {
        pg8::Gemm g{(const bf16_t*)(ws + WS_U), (const bf16_t*)(ws + WS_R), (const bf16_t*)(ws + WS_WPA), (const bf16_t*)(ws + WS_WPB), D, D, D, 1}; pg8::Order S; S.init(T, D, G, c, 2);
        pg8::EpiProj E{(const bf16_t*)p.out, (bf16_t*)(ws + WS_V)};
        pg8::gemm_phase(lds, g, S, E);
    }
    SEAM(5);
    if (IN(6)) {
        pg8::Gemm g{(const bf16_t*)(ws + WS_V), nullptr, (const bf16_t*)(ws + WS_WO), nullptr, D, D, D, 1}; pg8::Order S; S.init(T, D, G, c, 1);
        pg8::EpiResid<true, true, true> E{(const void*)(ws + WS_XB), 1.0f, (float*)(ws + WS_X2), (bf16_t*)(ws + WS_X2B), (float*)(ws + WS_SSQ2)};
        pg8::gemm_phase(lds, g, S, E);
    }
    SEAM(6);
    if (IN(7)) {
        pg8::Gemm g{(const bf16_t*)(ws + WS_X2B), nullptr, (const bf16_t*)(ws + WS_W2IN), nullptr, D, D, D, 1}; pg8::Order S; S.init(T, 2 * DFF, G, c, 1);
        pg8::EpiSwiGLU E{nullptr, (const float*)(ws + WS_SSQ2), (bf16_t*)(ws + WS_H2)};
        pg8::gemm_phase(lds, g, S, E);
    }
    SEAM(7);
    if (IN(8)) {
        pg8::Gemm g{(const bf16_t*)(ws + WS_H2), nullptr, (const bf16_t*)(ws + WS_W2OUT), nullptr, DFF, DFF, DFF, 1}; pg8::Order S; S.init(T, D, G, c, 1);
        pg8::EpiResid<false, true, false> E{(const void*)(ws + WS_X2), 0.5f, p.out, nullptr, nullptr};
        pg8::gemm_phase(lds, g, S, E);
    }
    SEAM(8);
    if (IN(9)) p9_final(p);
#undef IN
#undef SEAM
}

extern "C" void kernel_launch(void* const* d_in, const int* in_sizes, int n_in, void* d_out, int out_size, void* d_ws, size_t ws_size, hipStream_t stream) {
    static int grid = 0;
    if (grid == 0) {
        int dev = 0, cus = 0, per_cu = 0;
        (void)hipGetDevice(&dev);
        (void)hipDeviceGetAttribute(&cus, hipDeviceAttributeMultiprocessorCount, dev);
        (void)hipFuncSetAttribute((const void*)mega_fwd, hipFuncAttributeMaxDynamicSharedMemorySize, LDS_BYTES);
        (void)hipOccupancyMaxActiveBlocksPerMultiprocessor(&per_cu, (const void*)mega_fwd, NTHREADS, LDS_BYTES);
        if (per_cu < 1) { fprintf(stderr, "kernel_launch: occupancy query says %d blocks/CU\n", per_cu); per_cu = 1; }
        grid = cus;
        if (n_in != 21 || out_size != T * D || ws_size < WS_END) fprintf(stderr, "kernel_launch: unexpected sizes n_in %d out %d ws %zu\n", n_in, out_size, ws_size);
        fprintf(stderr, "kernel_launch: cus %d per_cu %d grid %d ws %zu\n", cus, per_cu, grid, ws_size);
    }
    Params p{};
    for (int i = 0; i < 21; ++i) p.in[i] = (const float*)d_in[i];
    p.out = (float*)d_out; p.ws = (unsigned char*)d_ws; p.ph_lo = 0; p.ph_hi = 10;
    void* args[] = {&p};
    hipError_t e = hipLaunchCooperativeKernel((const void*)mega_fwd, dim3(grid), dim3(NTHREADS), args, LDS_BYTES, stream);
    if (e != hipSuccess) fprintf(stderr, "cooperative launch failed: %s (grid %d)\n", hipGetErrorString(e), grid);
}
```

```cpp
#include <hip/hip_runtime.h>
#include <hip/hip_cooperative_groups.h>
#include <cstdio>
#include <cstdint>
namespace cg = cooperative_groups;

#define LAS __attribute__((address_space(3)))
typedef unsigned short bf16_t;
typedef short bf16x8 __attribute__((ext_vector_type(8)));
typedef float f32x4 __attribute__((ext_vector_type(4)));
typedef float f32x2 __attribute__((ext_vector_type(2)));
typedef unsigned u32x4 __attribute__((ext_vector_type(4)));
typedef unsigned u32x2 __attribute__((ext_vector_type(2)));
typedef float f32x8 __attribute__((ext_vector_type(8)));
typedef float f32x16 __attribute__((ext_vector_type(16)));
typedef __bf16 bf16x8_t __attribute__((ext_vector_type(8)));
typedef __bf16 bf16x2_t __attribute__((ext_vector_type(2)));

constexpr int T = 65536, D = 1024, DFF = 2816, SEQ = 8192;
constexpr int NWIN = 7680;
constexpr float EPS = 1e-6f;
constexpr int NTHREADS = 512;
constexpr int LDS_BYTES = 147456;

constexpr size_t MiB = (size_t)1 << 20;
constexpr size_t WS_RS0 = 1 * MiB;
constexpr size_t WS_SSQ1 = 2 * MiB;
constexpr size_t WS_SSQ2 = 6 * MiB;
constexpr size_t WS_LNST = 10 * MiB;
constexpr size_t WS_W1IN = 20 * MiB, WS_W1OUT = 31 * MiB, WS_WIN = 37 * MiB, WS_WPA = 52 * MiB, WS_WPB = 54 * MiB, WS_WO = 56 * MiB, WS_W2IN = 58 * MiB, WS_W2OUT = 69 * MiB;
constexpr size_t ACT0 = 76 * MiB;
constexpr size_t WS_XB = ACT0;
constexpr size_t WS_H = ACT0 + 128 * MiB;
constexpr size_t WS_U = ACT0 + 128 * MiB;
constexpr size_t WS_V = ACT0 + 256 * MiB;
constexpr size_t WS_Q = ACT0 + 384 * MiB;
constexpr size_t WS_K = ACT0 + 448 * MiB;
constexpr size_t WS_VB = ACT0 + 512 * MiB;
constexpr size_t WS_R = ACT0 + 640 * MiB;
constexpr size_t WS_LA = ACT0 + 768 * MiB;
constexpr size_t WS_X2 = ACT0 + 640 * MiB;
constexpr size_t WS_X2B = ACT0 + 128 * MiB;
constexpr size_t WS_H2 = ACT0 + 256 * MiB;
constexpr size_t WS_END = ACT0 + 896 * MiB;
static_assert(WS_END <= 1024 * MiB, "ws map");

__device__ __forceinline__ unsigned f2bf(float f) { unsigned u = __builtin_bit_cast(unsigned, f); return (u + 0x7fffu + ((u >> 16) & 1u)) >> 16; }
__device__ __forceinline__ unsigned pk2(float lo, float hi) { return f2bf(lo) | (f2bf(hi) << 16); }
__device__ __forceinline__ float bf2f(unsigned short b) { return __builtin_bit_cast(float, ((unsigned)b) << 16); }
__device__ __forceinline__ float bflo(unsigned w) { return __builtin_bit_cast(float, w << 16); }
__device__ __forceinline__ float bfhi(unsigned w) { return __builtin_bit_cast(float, w & 0xffff0000u); }
__device__ __forceinline__ float wave_sum(float v) {
#pragma unroll
    for (int o = 1; o < 64; o <<= 1) v += __shfl_xor(v, o);
    return v;
}

__device__ __forceinline__ bf16x8 cvt8(f32x8 v) { return __builtin_bit_cast(bf16x8, __builtin_convertvector(v, bf16x8_t)); }
__device__ __forceinline__ unsigned cvt2(float a, float b) { const f32x2 v = {a, b}; return __builtin_bit_cast(unsigned, __builtin_convertvector(v, bf16x2_t)); }

namespace pg8 {
constexpr int BM = 256, BK = 64, HALF = 128, HTB = HALF * BK * 2, STAGE_BYTES = 8 * HTB, NXCD = 8, WGM = 8;
__host__ __device__ __forceinline__ int lds_byte(int r, int c) { const int st = (r >> 4) * 2 + (c >> 5), rr = r & 15, cc = c & 31, ob = rr * 64 + cc * 2; return st * 1024 + (ob ^ (((ob >> 9) & 1) << 5)); }
__host__ __device__ __forceinline__ void stage_rc(int b, int& R, int& C) { const int st = b / 1024, sb = b % 1024, swz = sb ^ (((sb >> 9) & 1) << 5); R = (st >> 1) * 16 + swz / 64; C = (st & 1) * 32 + (swz % 64) / 2; }
__host__ __device__ __forceinline__ int perm32(int rho) { const int n = rho >> 4, i = rho & 15; return 8 * (i >> 2) + 4 * n + (i & 3); }

struct Unit { int pm, pn, seg; };
struct Gemm { const bf16_t *A0, *A1, *B0, *B1; int lda, ldb, K, nsh; };
__device__ __forceinline__ const char* a_ptr(const Gemm& g, const Unit& u) { const bool s = u.seg >= g.nsh; const bf16_t* b = s ? g.A1 : g.A0; const int ks = s ? u.seg - g.nsh : u.seg; return (const char*)(b + (size_t)u.pm * BM * g.lda + ks * g.K); }
__device__ __forceinline__ const char* b_ptr(const Gemm& g, const Unit& u) { const bool s = u.seg >= g.nsh; const bf16_t* b = s ? g.B1 : g.B0; const int ks = s ? u.seg - g.nsh : u.seg; return (const char*)(b + (size_t)u.pn * BM * g.ldb + ks * g.K); }

struct Order {
    int nM, nN, nwg, G, c, nseg;
    __device__ void init(int M, int N, int G_, int c_, int nseg_) { nM = M / BM; nN = N / BM; nwg = nM * nN; G = G_; c = c_; nseg = nseg_; }
    __device__ bool next(int i, Unit& u) const {
        const int ti = i / nseg; u.seg = i - ti * nseg;
        const long L = (long)ti * G + c; if (L >= nwg) return false;
        int wgid = (int)L; { const int q = nwg / NXCD, r = nwg % NXCD, xcd = wgid % NXCD, off = wgid / NXCD; wgid = (xcd < r ? xcd * (q + 1) : r * (q + 1) + (xcd - r) * q) + off; }
        const int nig = WGM * nN, gid = wgid / nig, fm = gid * WGM, gsz = (nM - fm) < WGM ? (nM - fm) : WGM;
        u.pm = fm + ((wgid % nig) % gsz); u.pn = (wgid % nig) / gsz; return true;
    }
};

__device__ __forceinline__ unsigned cvt_pk_bf16(float lo, float hi) { unsigned r; asm volatile("v_cvt_pk_bf16_f32 %0, %1, %2" : "=v"(r) : "v"(lo), "v"(hi)); return r; }
__device__ __forceinline__ f32x2 gelu_pk(f32x2 v) {
    const f32x2 av = __builtin_elementwise_abs(v), d = av * 0.2316418882f + 1.0f;
    f32x2 t; t.x = __builtin_amdgcn_rcpf(d.x); t.y = __builtin_amdgcn_rcpf(d.y);
    f32x2 q = t * 0.5307027145f + (-0.7265760135f); q = q * t + 0.7107068705f; q = q * t + (-0.142248368f); q = q * t + 0.127414796f; q = q * t;
    const f32x2 s = (v * v) * (-0.72134752044f);
    f32x2 e; e.x = __builtin_amdgcn_exp2f(s.x); e.y = __builtin_amdgcn_exp2f(s.y);
    const f32x2 m = v * (q * e), r = v - m;
    f32x2 o; o.x = v.x < 0.f ? m.x : r.x; o.y = v.y < 0.f ? m.y : r.y; return o;
}
__device__ __forceinline__ f32x4 gelu4(f32x4 v) { const f32x2 a = gelu_pk((f32x2){v[0], v[1]}), b = gelu_pk((f32x2){v[2], v[3]}); return (f32x4){a.x, a.y, b.x, b.y}; }
__device__ __forceinline__ float sigm(float x) { return __builtin_amdgcn_rcpf(1.0f + __expf(-x)); }
__device__ __forceinline__ f32x4 sigm4(f32x4 v) { return (f32x4){sigm(v[0]), sigm(v[1]), sigm(v[2]), sigm(v[3])}; }
__device__ __forceinline__ f32x4 silu4(f32x4 v) { return v * sigm4(v); }
__device__ __forceinline__ float lsig16(float x) { return (fminf(x, 0.f) - log1pf(__expf(-fabsf(x)))) * 0.0625f; }
__device__ __forceinline__ f32x4 lsig4(f32x4 v) { return (f32x4){lsig16(v[0]), lsig16(v[1]), lsig16(v[2]), lsig16(v[3])}; }
__device__ __forceinline__ u32x4 pack8(f32x4 v0, f32x4 v1) { u32x4 w; w.x = cvt_pk_bf16(v0[0], v0[1]); w.y = cvt_pk_bf16(v0[2], v0[3]); w.z = cvt_pk_bf16(v1[0], v1[1]); w.w = cvt_pk_bf16(v1[2], v1[3]); return w; }
__device__ __forceinline__ void unpack8(u32x4 w, f32x4& v0, f32x4& v1) { v0 = (f32x4){bflo(w.x), bfhi(w.x), bflo(w.y), bfhi(w.y)}; v1 = (f32x4){bflo(w.z), bfhi(w.z), bflo(w.w), bfhi(w.w)}; }
__device__ __forceinline__ float row_rs16(const float* ssq, int row, int fq) {
    const f32x4 v = *(const f32x4*)(ssq + (size_t)row * 16 + 4 * fq); float s = (v[0] + v[1]) + (v[2] + v[3]);
    s += __shfl_xor(s, 16); s += __shfl_xor(s, 32);
    return 1.0f / sqrtf(s * (1.0f / 1024.0f) + EPS);
}

typedef f32x4 Acc[2][2][4][2];

struct EpiSwiGLU {
    const float* rs_direct;
    const float* ssq;
    bf16_t* H;
    __device__ __forceinline__ bool keep(const Unit&) const { return false; }
    __device__ __forceinline__ void operator()(Acc& acc, const Unit& u, int wr, int wc, int fr, int fq) const {
        const int row0 = u.pm * BM + wr * 64 + fr, col0 = u.pn * 128 + wc * 32 + 8 * fq;
        float rsv[2][4];
#pragma unroll
        for (int ai = 0; ai < 2; ++ai)
#pragma unroll
            for (int m = 0; m < 4; ++m) { const int row = row0 + ai * HALF + m * 16; rsv[ai][m] = rs_direct ? rs_direct[row] : row_rs16(ssq, row, fq); }
#pragma unroll
        for (int ai = 0; ai < 2; ++ai)
#pragma unroll
            for (int m = 0; m < 4; ++m) { const int row = row0 + ai * HALF + m * 16;
                const float rs = rsv[ai][m];
                const f32x4 a0 = acc[ai][0][m][0] * rs, a1 = acc[ai][0][m][1] * rs, b0 = acc[ai][1][m][0] * rs, b1 = acc[ai][1][m][1] * rs;
                *(u32x4*)(H + (size_t)row * DFF + col0) = pack8(silu4(a0) * b0, silu4(a1) * b1); }
    }
};
template <bool BASE_BF16, bool OUT_F32, bool OUT_BF16> struct EpiResid {
    const void* base; float scale; float* of32; bf16_t* obf; float* ssq;
    __device__ __forceinline__ bool keep(const Unit&) const { return false; }
    __device__ __forceinline__ void operator()(Acc& acc, const Unit& u, int wr, int wc, int fr, int fq) const {
        const int row0 = u.pm * BM + wr * 64 + fr, col0 = u.pn * BM + wc * 32 + 8 * fq;
#pragma unroll
        for (int ai = 0; ai < 2; ++ai)
#pragma unroll
            for (int m = 0; m < 4; ++m) { const int row = row0 + ai * HALF + m * 16; const size_t off = (size_t)row * D + col0; float q = 0.f;
#pragma unroll
                for (int bj = 0; bj < 2; ++bj) { f32x4 b0, b1;
                    if (BASE_BF16) unpack8(*(const u32x4*)((const bf16_t*)base + off + bj * HALF), b0, b1);
                    else { b0 = *(const f32x4*)((const float*)base + off + bj * HALF); b1 = *(const f32x4*)((const float*)base + off + bj * HALF + 4); }
                    const f32x4 v0 = b0 + acc[ai][bj][m][0] * scale, v1 = b1 + acc[ai][bj][m][1] * scale;
                    q += (v0[0] * v0[0] + v0[1] * v0[1]) + (v0[2] * v0[2] + v0[3] * v0[3]) + (v1[0] * v1[0] + v1[1] * v1[1]) + (v1[2] * v1[2] + v1[3] * v1[3]);
                    if (OUT_F32) { *(f32x4*)(of32 + off + bj * HALF) = v0; *(f32x4*)(of32 + off + bj * HALF + 4) = v1; }
                    if (OUT_BF16) *(u32x4*)(obf + off + bj * HALF) = pack8(v0, v1); }
                q += __shfl_xor(q, 16); q += __shfl_xor(q, 32);
                if (ssq && fq == 0) ssq[(size_t)row * 16 + 4 * u.pn + wc] = q; }
    }
};
struct EpiWin {
    const float* ssq; bf16_t *U, *V, *Q, *Kb, *VB, *R, *G, *LA; float* lnst; const float *b_gate, *b_alpha;
    __device__ __forceinline__ bool keep(const Unit&) const { return false; }
    __device__ __forceinline__ void operator()(Acc& acc, const Unit& u, int wr, int wc, int fr, int fq) const {
        const int pn = u.pn; int kind, ld, colt; bf16_t* basep; const float* bias = nullptr; float sc = 1.f; bool stats = false;
        if (pn < 4) { kind = 1; basep = U; ld = 1024; colt = 256 * pn; }
        else if (pn < 8) { kind = 1; basep = V; ld = 1024; colt = 256 * (pn - 4); stats = true; }
        else if (pn < 10) { kind = 0; basep = Q; ld = 512; colt = 256 * (pn - 8); sc = 0.08838834764831845f; }
        else if (pn < 12) { kind = 0; basep = Kb; ld = 512; colt = 256 * (pn - 10); }
        else if (pn < 16) { kind = 0; basep = VB; ld = 1024; colt = 256 * (pn - 12); }
        else if (pn < 20) { kind = 2; basep = R; ld = 1024; colt = 256 * (pn - 16); }
        else if (pn < 28) { kind = 3; basep = G; ld = 2048; colt = 256 * (pn - 20); bias = b_gate; }
        else { kind = 4; basep = LA; ld = 512; colt = 256 * (pn - 28); bias = b_alpha; }
        const int row0 = u.pm * BM + wr * 64 + fr, col0 = colt + wc * 32 + 8 * fq;
        f32x4 bv[2][2];
#pragma unroll
        for (int bj = 0; bj < 2; ++bj)
#pragma unroll
            for (int n = 0; n < 2; ++n) bv[bj][n] = bias ? *(const f32x4*)(bias + col0 + bj * HALF + 4 * n) : (f32x4){0.f, 0.f, 0.f, 0.f};
        float rsv[2][4];
#pragma unroll
        for (int ai = 0; ai < 2; ++ai)
#pragma unroll
            for (int m = 0; m < 4; ++m) rsv[ai][m] = row_rs16(ssq, row0 + ai * HALF + m * 16, fq) * sc;
#pragma unroll
        for (int ai = 0; ai < 2; ++ai)
#pragma unroll
            for (int m = 0; m < 4; ++m) { const int row = row0 + ai * HALF + m * 16; const float rs = rsv[ai][m]; float s1 = 0.f, s2 = 0.f;
                bf16_t* rowp = basep + (size_t)row * ld + col0;
#pragma unroll
                for (int bj = 0; bj < 2; ++bj) { f32x4 v0 = acc[ai][bj][m][0] * rs + bv[bj][0], v1 = acc[ai][bj][m][1] * rs + bv[bj][1];
                    if (kind == 1) { v0 = gelu4(v0); v1 = gelu4(v1); }
                    else if (kind == 2) { v0 = silu4(v0); v1 = silu4(v1); }
                    else if (kind == 3) { v0 = sigm4(v0); v1 = sigm4(v1); }
                    else if (kind == 4) { v0 = lsig4(v0); v1 = lsig4(v1); }
                    s1 += (v0[0] + v0[1]) + (v0[2] + v0[3]) + (v1[0] + v1[1]) + (v1[2] + v1[3]);
                    s2 += (v0[0] * v0[0] + v0[1] * v0[1]) + (v0[2] * v0[2] + v0[3] * v0[3]) + (v1[0] * v1[0] + v1[1] * v1[1]) + (v1[2] * v1[2] + v1[3] * v1[3]);
                    *(u32x4*)(rowp + bj * HALF) = pack8(v0, v1); }
                if (stats) { s1 += __shfl_xor(s1, 16); s1 += __shfl_xor(s1, 32); s2 += __shfl_xor(s2, 16); s2 += __shfl_xor(s2, 32);
                    if (fq == 0) *(f32x2*)(lnst + ((size_t)row * 16 + 4 * (pn - 4) + wc) * 2) = (f32x2){s1, s2}; } }
    }
};
struct EpiProj {
    const bf16_t* G; bf16_t* Mb;
    __device__ __forceinline__ bool keep(const Unit& u) const { return u.seg == 0; }
    __device__ __forceinline__ void operator()(Acc& acc, const Unit& u, int wr, int wc, int fr, int fq) const {
        const int row0 = u.pm * BM + wr * 64 + fr, col0 = u.pn * BM + wc * 32 + 8 * fq;
#pragma unroll
        for (int ai = 0; ai < 2; ++ai)
#pragma unroll
            for (int m = 0; m < 4; ++m) { const int row = row0 + ai * HALF + m * 16;
#pragma unroll
                for (int bj = 0; bj < 2; ++bj) { const bf16_t* gp = G + (size_t)row * 2048 + col0 + bj * HALF;
                    f32x4 sb0, sb1; unpack8(*(const u32x4*)(gp + 1024), sb0, sb1);
                    if (u.seg == 0) { f32x4 sa0, sa1; unpack8(*(const u32x4*)gp, sa0, sa1);
#pragma unroll
                        for (int e = 0; e < 4; ++e) { acc[ai][bj][m][0][e] *= sa0[e] * __builtin_amdgcn_rcpf(fmaxf(sb0[e], 1e-30f)); acc[ai][bj][m][1][e] *= sa1[e] * __builtin_amdgcn_rcpf(fmaxf(sb1[e], 1e-30f)); } }
                    else *(u32x4*)(Mb + (size_t)row * D + col0 + bj * HALF) = pack8(acc[ai][bj][m][0] * sb0, acc[ai][bj][m][1] * sb1); } }
    }
};

template <class Epi>
__device__ __forceinline__ void gemm_phase(LAS unsigned char* lds, const Gemm g, const Order& S, const Epi& E) {
    const int tid = threadIdx.x, wid = __builtin_amdgcn_readfirstlane(tid >> 6), lane = tid & 63, wr = wid >> 2, wc = wid & 3, fr = lane & 15, fq = lane >> 4;
    const int nt = g.K / BK;
    unsigned voffA[2], voffB[2];
#pragma unroll
    for (int i = 0; i < 2; ++i) { int R, C; stage_rc(tid * 16 + i * 8192, R, C); const int Rb = (R & ~31) + perm32(R & 31);
        voffA[i] = (unsigned)(R * g.lda + C) * 2u; voffB[i] = (unsigned)(Rb * g.ldb + C) * 2u; }
    const size_t kstep = (size_t)(BK * 2);
    const size_t hstepA = (size_t)HALF * g.lda * 2, hstepB = (size_t)HALF * g.ldb * 2;
    const unsigned ldsw = (unsigned)wid * 1024u;
    const int aoff = lds_byte(wr * 64 + fr, fq * 8), boff = lds_byte(wc * 32 + fr, fq * 8);
#define PG8_SA(b, h) (((b) * 2 + (h)) * HTB)
#define PG8_SB(b, h) ((4 + (b) * 2 + (h)) * HTB)
#define PG8_STAGE(bufoff, gbase, voff) do { _Pragma("unroll") for (int _i = 0; _i < 2; ++_i) \
        __builtin_amdgcn_global_load_lds((const unsigned*)((const char*)(gbase) + (voff)[_i]), (LAS unsigned*)(lds + (bufoff) + ldsw + _i * 8192), 16, 0, 0); } while (0)
#define PG8_LDA(dst, b, h) do { _Pragma("unroll") for (int m = 0; m < 4; ++m) _Pragma("unroll") for (int k = 0; k < 2; ++k) dst[m][k] = *(const LAS bf16x8*)(lds + PG8_SA(b, h) + aoff + m * 2048 + k * 1024); } while (0)
#define PG8_LDB(dst, b, h) do { _Pragma("unroll") for (int n = 0; n < 2; ++n) _Pragma("unroll") for (int k = 0; k < 2; ++k) dst[n][k] = *(const LAS bf16x8*)(lds + PG8_SB(b, h) + boff + n * 2048 + k * 1024); } while (0)
#define PG8_MMA(ai, bj, At, Bt) do { __builtin_amdgcn_s_setprio(1); _Pragma("unroll") for (int m = 0; m < 4; ++m) _Pragma("unroll") for (int n = 0; n < 2; ++n) _Pragma("unroll") for (int k = 0; k < 2; ++k) \
        acc[ai][bj][m][n] = __builtin_amdgcn_mfma_f32_16x16x32_bf16(Bt[n][k], At[m][k], acc[ai][bj][m][n], 0, 0, 0); __builtin_amdgcn_s_setprio(0); } while (0)
#define PG8_WAIT_V(n) asm volatile("s_waitcnt vmcnt(" #n ")" ::: "memory")
#define PG8_WAIT_L(n) asm volatile("s_waitcnt lgkmcnt(" #n ")" ::: "memory")
#define PG8_BAR __builtin_amdgcn_s_barrier()
#define PG8_SCHED __builtin_amdgcn_sched_barrier(0)
    Unit cur, nxt; int ui = 0;
    if (!S.next(0, cur)) return;
    Acc acc;
#pragma unroll
    for (int a = 0; a < 2; ++a)
#pragma unroll
        for (int b = 0; b < 2; ++b)
#pragma unroll
            for (int m = 0; m < 4; ++m)
#pragma unroll
                for (int n = 0; n < 2; ++n) acc[a][b][m][n] = (f32x4){0.f, 0.f, 0.f, 0.f};
    bf16x8 At[4][2], B0[2][2], B1[2][2];
    const char* cA = a_ptr(g, cur); const char* cB = b_ptr(g, cur);
    PG8_STAGE(PG8_SB(0, 0), cB, voffB); PG8_STAGE(PG8_SB(0, 1), cB + hstepB, voffB); PG8_STAGE(PG8_SA(0, 0), cA, voffA); PG8_STAGE(PG8_SA(0, 1), cA + hstepA, voffA);
    if (wr == 1) PG8_BAR;
    PG8_WAIT_V(2); PG8_BAR;
    PG8_STAGE(PG8_SB(1, 0), cB + kstep, voffB); PG8_STAGE(PG8_SA(1, 0), cA + kstep, voffA); PG8_STAGE(PG8_SB(1, 1), cB + hstepB + kstep, voffB);
    PG8_WAIT_V(6); PG8_BAR;
    for (;;) {
        const bool has_next = S.next(ui + 1, nxt);
        const char* nA = has_next ? a_ptr(g, nxt) : cA; const char* nB = has_next ? b_ptr(g, nxt) : cB;
        for (int t = 0; t < nt; t += 2) {
            const bool last = (t == nt - 2);
            const char* a1 = cA + (size_t)(t + 1) * kstep;
            const char* a2 = last ? nA : cA + (size_t)(t + 2) * kstep; const char* b2 = last ? nB : cB + (size_t)(t + 2) * kstep;
            const char* a3 = a2 + kstep; const char* b3 = b2 + kstep;
            PG8_LDB(B0, 0, 0); PG8_LDB(B1, 0, 1); PG8_SCHED; PG8_LDA(At, 0, 0); PG8_STAGE(PG8_SA(1, 1), a1 + hstepA, voffA);
            PG8_WAIT_V(8); PG8_WAIT_L(0); PG8_BAR; PG8_MMA(0, 0, At, B0); PG8_MMA(0, 1, At, B1); PG8_BAR; PG8_SCHED;
            PG8_LDA(At, 0, 1); PG8_STAGE(PG8_SB(0, 0), b2, voffB); PG8_STAGE(PG8_SB(0, 1), b2 + hstepB, voffB); PG8_STAGE(PG8_SA(0, 0), a2, voffA);
            PG8_WAIT_V(8); PG8_WAIT_L(0); PG8_BAR; PG8_MMA(1, 0, At, B0); PG8_MMA(1, 1, At, B1); PG8_BAR; PG8_SCHED;
            PG8_LDB(B0, 1, 0); PG8_LDB(B1, 1, 1); PG8_SCHED; PG8_LDA(At, 1, 0); PG8_STAGE(PG8_SA(0, 1), a2 + hstepA, voffA);
            PG8_WAIT_V(8); PG8_WAIT_L(0); PG8_BAR; PG8_MMA(0, 0, At, B0); PG8_MMA(0, 1, At, B1); PG8_BAR; PG8_SCHED;
            PG8_LDA(At, 1, 1); PG8_STAGE(PG8_SB(1, 0), b3, voffB); PG8_STAGE(PG8_SB(1, 1), b3 + hstepB, voffB); PG8_STAGE(PG8_SA(1, 0), a3, voffA);
            PG8_WAIT_V(8); PG8_WAIT_L(0); PG8_BAR; PG8_MMA(1, 0, At, B0); PG8_MMA(1, 1, At, B1); PG8_BAR; PG8_SCHED;
        }
        if (wr == 0) PG8_BAR;
        E(acc, cur, wr, wc, fr, fq);
        if (!has_next) break;
        if (!E.keep(cur)) {
#pragma unroll
            for (int a = 0; a < 2; ++a)
#pragma unroll
                for (int b = 0; b < 2; ++b)
#pragma unroll
                    for (int m = 0; m < 4; ++m)
#pragma unroll
                        for (int n = 0; n < 2; ++n) acc[a][b][m][n] = (f32x4){0.f, 0.f, 0.f, 0.f};
        }
        cur = nxt; cA = nA; cB = nB; ++ui;
        if (wr == 1) PG8_BAR;
    }
    PG8_WAIT_V(0);
    PG8_BAR;
#undef PG8_SA
#undef PG8_SB
#undef PG8_STAGE
#undef PG8_LDA
#undef PG8_LDB
#undef PG8_MMA
#undef PG8_WAIT_V
#undef PG8_WAIT_L
#undef PG8_BAR
#undef PG8_SCHED
}
}

struct Params {
    const float* in[21];
    float* out;
    unsigned char* ws;
    int ph_lo, ph_hi;
};
enum { I_X = 0, I_F1N, I_F1WI, I_F1WO, I_MIXN, I_WIN, I_BGATE, I_ALNG, I_ALNB, I_AWS, I_ABS, I_BWA, I_BBA, I_BHN, I_WPA, I_WPB, I_WO, I_F2N, I_F2WI, I_F2WO, I_FINN };

__device__ __forceinline__ void transpose_item(const float* W, int ldw, int src_col0, const float* gain, bf16_t* WT, int K, int dst_row0, int k0, LAS float* scr, int lane) {
#pragma unroll 8
    for (int i = 0; i < 32; ++i) { const int kk = 2 * i + (lane >> 5); float v = W[(size_t)(k0 + kk) * ldw + src_col0 + (lane & 31)]; if (gain) v *= gain[k0 + kk]; scr[kk * 33 + (lane & 31)] = v; }
    asm volatile("s_waitcnt lgkmcnt(0)" ::: "memory");
    const int c = lane & 7;
#pragma unroll
    for (int j = 0; j < 4; ++j) { const int n = (lane >> 3) + 8 * j; const LAS float* s = scr + (8 * c) * 33 + n;
        u32x4 o; o.x = pk2(s[0 * 33], s[1 * 33]); o.y = pk2(s[2 * 33], s[3 * 33]); o.z = pk2(s[4 * 33], s[5 * 33]); o.w = pk2(s[6 * 33], s[7 * 33]);
        *(u32x4*)(WT + (size_t)(dst_row0 + n) * K + k0 + 8 * c) = o; }
    asm volatile("s_waitcnt lgkmcnt(0)" ::: "memory");
}
__device__ __forceinline__ void transpose_matrix_item(int it, int kind, const float* W, int ldw, int K, int ndst, const float* gain, bf16_t* WT, LAS float* scr, int lane) {
    const int nblk = ndst / 32, kb = it / nblk, nb = it % nblk, n0 = 32 * nb; int src;
    if (kind == 1) { const int pn = nb >> 3, w = nb & 7; src = (w >> 2) * DFF + 128 * pn + 32 * (w & 3); }
    else if (kind == 2) src = n0 < 5120 ? n0 : n0 + 16;
    else src = n0;
    transpose_item(W, ldw, src, gain, WT, K, n0, 64 * kb, scr, lane);
}
__device__ __forceinline__ void p0_prep(const Params& p, LAS unsigned char* lds) {
    const int tid = threadIdx.x, lane = tid & 63, wave = tid >> 6;
    const int gw = blockIdx.x * 8 + wave, NGW = gridDim.x * 8;
    LAS float* scr = (LAS float*)(lds + wave * 16384);
    unsigned char* ws = p.ws;
    constexpr int I_FI = (D / 64) * (2 * DFF / 32), I_FO = (DFF / 64) * (D / 32), I_WI = (D / 64) * (7168 / 32), I_SQ = (D / 64) * (D / 32);
    constexpr int NITEMS = 2 * I_FI + 2 * I_FO + I_WI + 3 * I_SQ;
    for (int it = gw; it < NITEMS; it += NGW) {
        int r = it;
        if (r < I_FI) { transpose_matrix_item(r, 1, p.in[I_F1WI], 2 * DFF, D, 2 * DFF, p.in[I_F1N], (bf16_t*)(ws + WS_W1IN), scr, lane); continue; } r -= I_FI;
        if (r < I_FI) { transpose_matrix_item(r, 1, p.in[I_F2WI], 2 * DFF, D, 2 * DFF, p.in[I_F2N], (bf16_t*)(ws + WS_W2IN), scr, lane); continue; } r -= I_FI;
        if (r < I_FO) { transpose_matrix_item(r, 0, p.in[I_F1WO], D, DFF, D, nullptr, (bf16_t*)(ws + WS_W1OUT), scr, lane); continue; } r -= I_FO;
        if (r < I_FO) { transpose_matrix_item(r, 0, p.in[I_F2WO], D, DFF, D, nullptr, (bf16_t*)(ws + WS_W2OUT), scr, lane); continue; } r -= I_FO;
        if (r < I_WI) { transpose_matrix_item(r, 2, p.in[I_WIN], 7184, D, 7168, p.in[I_MIXN], (bf16_t*)(ws + WS_WIN), scr, lane); continue; } r -= I_WI;
        if (r < I_SQ) { transpose_matrix_item(r, 0, p.in[I_WPA], D, D, D, nullptr, (bf16_t*)(ws + WS_WPA), scr, lane); continue; } r -= I_SQ;
        if (r < I_SQ) { transpose_matrix_item(r, 0, p.in[I_WPB], D, D, D, nullptr, (bf16_t*)(ws + WS_WPB), scr, lane); continue; } r -= I_SQ;
        transpose_matrix_item(r, 0, p.in[I_WO], D, D, D, nullptr, (bf16_t*)(ws + WS_WO), scr, lane);
    }
    {
        bf16_t* WT = (bf16_t*)(ws + WS_WIN) + (size_t)7168 * D; const float* W = p.in[I_WIN]; const float* wa = p.in[I_BWA]; const float* gn = p.in[I_MIXN];
        for (int idx = blockIdx.x * NTHREADS + tid; idx < 512 * D; idx += gridDim.x * NTHREADS) { const int n = idx >> 10, k = idx & 1023; float s = 0.f;
#pragma unroll
            for (int r = 0; r < 16; ++r) s += W[(size_t)k * 7184 + 5120 + r] * wa[r * 512 + n];
            WT[idx] = (bf16_t)f2bf(s * gn[k]); }
    }
    {
        const float* x = p.in[I_X]; bf16_t* xb = (bf16_t*)(ws + WS_XB); float* rs0 = (float*)(ws + WS_RS0);
        for (int m = gw; m < T; m += NGW) { const f32x4* xr = (const f32x4*)(x + (size_t)m * D) + lane; unsigned long long* o8 = (unsigned long long*)(xb + (size_t)m * D) + lane; float s = 0.f;
#pragma unroll
            for (int j = 0; j < 4; ++j) { const f32x4 v = xr[64 * j]; s += (v[0] * v[0] + v[1] * v[1]) + (v[2] * v[2] + v[3] * v[3]); o8[64 * j] = (unsigned long long)pk2(v[0], v[1]) | ((unsigned long long)pk2(v[2], v[3]) << 32); }
            s = wave_sum(s); if (lane == 0) rs0[m] = 1.0f / sqrtf(s * (1.0f / D) + EPS); }
    }
}

__device__ __forceinline__ void p4_gmlp_simple(const Params& p, LAS unsigned char* lds) {
    const int tid = threadIdx.x;
    unsigned char* ws = p.ws;
    bf16_t* U = (bf16_t*)(ws + WS_U); const bf16_t* V = (const bf16_t*)(ws + WS_V); const float* lnst = (const float*)(ws + WS_LNST);
    const float* lg = p.in[I_ALNG]; const float* lb = p.in[I_ALNB]; const float* Wsg = p.in[I_AWS]; const float* bs = p.in[I_ABS];
    LAS float* Wsm = (LAS float*)lds;
    LAS float* vln = Wsm + 128 * 128;
    LAS float* mu = vln + 128 * 128;
    LAS float* rstd = mu + 128;
    const int g = blockIdx.x & 7;
    for (int e = tid; e < 128 * 128; e += NTHREADS) { const int i = e >> 7, j = e & 127; Wsm[e] = (j <= i) ? Wsg[(size_t)g * 16384 + e] : 0.f; }
    const int c = tid & 127, iq = tid >> 7;
    for (int tile = blockIdx.x; tile < 4096; tile += gridDim.x) {
        const int chunk = tile >> 3; const size_t t0 = (size_t)chunk * 128;
        __syncthreads();
        if (tid < 128) { const float* st = lnst + (t0 + tid) * 32; float s1 = 0.f, s2 = 0.f;
#pragma unroll
            for (int q = 0; q < 16; ++q) { s1 += st[2 * q]; s2 += st[2 * q + 1]; }
            const float mean = s1 * (1.0f / 1024.0f), var = s2 * (1.0f / 1024.0f) - mean * mean; mu[tid] = mean; rstd[tid] = 1.0f / sqrtf(fmaxf(var, 0.f) + EPS); }
        __syncthreads();
        for (int e = tid; e < 128 * 128; e += NTHREADS) { const int j = e >> 7, cc = e & 127; const float v = bf2f(V[(t0 + j) * 1024 + g * 128 + cc]);
            vln[e] = (v - mu[j]) * rstd[j] * lg[g * 128 + cc] + lb[g * 128 + cc]; }
        __syncthreads();
        float acc[32];
#pragma unroll
        for (int ii = 0; ii < 32; ++ii) acc[ii] = 0.f;
        const int jmax = (iq + 1) * 32;
        for (int j = 0; j < jmax; j += 4) {
            const float v0 = vln[(j + 0) * 128 + c], v1 = vln[(j + 1) * 128 + c], v2 = vln[(j + 2) * 128 + c], v3 = vln[(j + 3) * 128 + c];
#pragma unroll
            for (int ii = 0; ii < 32; ++ii) { const f32x4 w = *(const LAS f32x4*)(Wsm + (iq * 32 + ii) * 128 + j); acc[ii] += (w[0] * v0 + w[1] * v1) + (w[2] * v2 + w[3] * v3); }
        }
#pragma unroll
        for (int ii = 0; ii < 32; ++ii) { const int i = iq * 32 + ii; const size_t idx = (t0 + i) * 1024 + g * 128 + c;
            U[idx] = (bf16_t)f2bf(bf2f(U[idx]) * (acc[ii] + bs[g * 128 + i])); }
    }
    __syncthreads();
}

__device__ __forceinline__ void p4_gla_simple(const Params& p, LAS unsigned char* lds) {
    if (blockIdx.x >= 32) return;
    const int tid = threadIdx.x, lane = tid & 63, wave = tid >> 6;
    unsigned char* ws = p.ws;
    const bf16_t* Q = (const bf16_t*)(ws + WS_Q); const bf16_t* Kb = (const bf16_t*)(ws + WS_K); const bf16_t* VB = (const bf16_t*)(ws + WS_VB); const bf16_t* LA = (const bf16_t*)(ws + WS_LA);
    bf16_t* R = (bf16_t*)(ws + WS_R); const float* hg = p.in[I_BHN];
    const int b = blockIdx.x >> 2, h = blockIdx.x & 3, v = tid & 255, kh = tid >> 8;
    LAS float* qs = (LAS float*)lds; LAS float* ks = qs + 2048; LAS float* as = ks + 2048; LAS float* obuf = as + 2048; LAS float* red = obuf + 8192;
    float S[64];
#pragma unroll
    for (int i = 0; i < 64; ++i) S[i] = 0.f;
    const float hgv = hg[h * 256 + v];
    for (int t0 = 0; t0 < SEQ; t0 += 16) {
#pragma unroll
        for (int e = 0; e < 4; ++e) { const int idx = tid + 512 * e, tt = idx >> 7, k = idx & 127; const size_t row = (size_t)b * SEQ + t0 + tt;
            qs[idx] = bf2f(Q[row * 512 + h * 128 + k]); ks[idx] = bf2f(Kb[row * 512 + h * 128 + k]); as[idx] = __expf(bf2f(LA[row * 512 + h * 128 + k])); }
        __syncthreads();
        for (int tt = 0; tt < 16; ++tt) {
            const size_t row = (size_t)b * SEQ + t0 + tt; const float vv = bf2f(VB[row * 1024 + h * 256 + v]); float o = 0.f;
#pragma unroll
            for (int k4 = 0; k4 < 16; ++k4) { const f32x4 a4 = *(const LAS f32x4*)(as + tt * 128 + 64 * kh + 4 * k4), kk4 = *(const LAS f32x4*)(ks + tt * 128 + 64 * kh + 4 * k4), q4 = *(const LAS f32x4*)(qs + tt * 128 + 64 * kh + 4 * k4);
#pragma unroll
                for (int e = 0; e < 4; ++e) { S[4 * k4 + e] = a4[e] * S[4 * k4 + e] + kk4[e] * vv; o += q4[e] * S[4 * k4 + e]; } }
            obuf[(kh * 16 + tt) * 256 + v] = o;
        }
        __syncthreads();
        float oo[8];
#pragma unroll
        for (int j = 0; j < 8; ++j) { const int tt = kh * 8 + j; const float o = obuf[tt * 256 + v] + obuf[(16 + tt) * 256 + v]; oo[j] = o; const float s = wave_sum(o * o); if (lane == 0) red[tt * 4 + (wave & 3)] = s; }
        __syncthreads();
#pragma unroll
        for (int j = 0; j < 8; ++j) { const int tt = kh * 8 + j; const float ss = (red[tt * 4] + red[tt * 4 + 1]) + (red[tt * 4 + 2] + red[tt * 4 + 3]); const float rs = 1.0f / sqrtf(ss * (1.0f / 256.0f) + EPS);
            const size_t idx = ((size_t)b * SEQ + t0 + tt) * 1024 + h * 256 + v; R[idx] = (bf16_t)f2bf(oo[j] * rs * hgv * bf2f(R[idx])); }
        __syncthreads();
    }
}


namespace gm {
constexpr int WP = 272;
constexpr int OFF_WS = 0, OFF_VT = 128 * WP, OFF_MU = 2 * 128 * WP, OFF_RS = OFF_MU + 512;
}
__device__ __forceinline__ void p4_gmlp(const Params& p, LAS unsigned char* lds, int first_blk) {
    const int tid = threadIdx.x, lane = tid & 63, wave = __builtin_amdgcn_readfirstlane(tid >> 6), r = lane & 31, hh = lane >> 5;
    unsigned char* ws = p.ws;
    bf16_t* U = (bf16_t*)(ws + WS_U); const bf16_t* V = (const bf16_t*)(ws + WS_V); const float* lnst = (const float*)(ws + WS_LNST);
    const float* lg = p.in[I_ALNG]; const float* lb = p.in[I_ALNB]; const float* Wsg = p.in[I_AWS]; const float* bs = p.in[I_ABS];
    LAS float* mu = (LAS float*)(lds + gm::OFF_MU); LAS float* rstd = (LAS float*)(lds + gm::OFF_RS);
    const int nblk = gridDim.x - first_blk; int cur_g = -1;
    const int it = wave >> 1, ct0 = 2 * (wave & 1);
    for (int tile = blockIdx.x - first_blk; tile < 4096; tile += nblk) {
        const int g = tile & 7, chunk = tile >> 3; const size_t t0 = (size_t)chunk * 128;
        __syncthreads();
        if (g != cur_g) { cur_g = g;
            for (int e = tid; e < 128 * 64; e += NTHREADS) { const int i = e >> 6, j = 2 * (e & 63); const f32x2 w = *(const f32x2*)(Wsg + (size_t)g * 16384 + i * 128 + j);
                *(LAS unsigned*)(lds + gm::OFF_WS + i * gm::WP + 2 * j) = cvt2(j <= i ? w.x : 0.f, j + 1 <= i ? w.y : 0.f); } }
        if (tid < 128) { const f32x4* st = (const f32x4*)(lnst + (t0 + tid) * 32); float s1 = 0.f, s2 = 0.f;
#pragma unroll
            for (int q = 0; q < 8; ++q) { const f32x4 v = st[q]; s1 += v[0] + v[2]; s2 += v[1] + v[3]; }
            const float mean = s1 * (1.0f / 1024.0f), var = s2 * (1.0f / 1024.0f) - mean * mean; mu[tid] = mean; rstd[tid] = 1.0f / sqrtf(fmaxf(var, 0.f) + EPS); }
        const int cp = lane, jg = wave; unsigned vw[16];
#pragma unroll
        for (int jj = 0; jj < 16; ++jj) vw[jj] = *(const unsigned*)(V + (t0 + 16 * jg + jj) * 1024 + g * 128 + 2 * cp);
        const f32x2 lgv = *(const f32x2*)(lg + g * 128 + 2 * cp), lbv = *(const f32x2*)(lb + g * 128 + 2 * cp);
        __syncthreads();
        {
            f32x8 a0[2], a1[2];
#pragma unroll
            for (int jj = 0; jj < 16; ++jj) { const float m = mu[16 * jg + jj], rs = rstd[16 * jg + jj];
                a0[jj >> 3][jj & 7] = (bflo(vw[jj]) - m) * rs * lgv.x + lbv.x; a1[jj >> 3][jj & 7] = (bfhi(vw[jj]) - m) * rs * lgv.y + lbv.y; }
#pragma unroll
            for (int q = 0; q < 2; ++q) { *(LAS bf16x8*)(lds + gm::OFF_VT + (2 * cp) * gm::WP + 2 * (16 * jg + 8 * q)) = cvt8(a0[q]); *(LAS bf16x8*)(lds + gm::OFF_VT + (2 * cp + 1) * gm::WP + 2 * (16 * jg + 8 * q)) = cvt8(a1[q]); }
        }
        __syncthreads();
        f32x16 acc[2];
#pragma unroll
        for (int cc = 0; cc < 2; ++cc)
#pragma unroll
            for (int e = 0; e < 16; ++e) acc[cc][e] = 0.f;
        const int nks = 2 * it + 2;
        for (int ks = 0; ks < nks; ++ks) {
            const bf16x8 B = *(const LAS bf16x8*)(lds + gm::OFF_WS + (32 * it + r) * gm::WP + 2 * (16 * ks + 8 * hh));
#pragma unroll
            for (int cc = 0; cc < 2; ++cc) { const bf16x8 A = *(const LAS bf16x8*)(lds + gm::OFF_VT + (32 * (ct0 + cc) + r) * gm::WP + 2 * (16 * ks + 8 * hh));
                acc[cc] = __builtin_amdgcn_mfma_f32_32x32x16_bf16(A, B, acc[cc], 0, 0, 0); }
        }
        const int i = 32 * it + r; const float bsv = bs[g * 128 + i];
#pragma unroll
        for (int cc = 0; cc < 2; ++cc)
#pragma unroll
            for (int g4 = 0; g4 < 4; ++g4) { const int c0 = 32 * (ct0 + cc) + 8 * g4 + 4 * hh; bf16_t* up = U + (t0 + i) * 1024 + g * 128 + c0; const u32x2 uw = *(const u32x2*)up;
                u32x2 o; o.x = cvt2(bflo(uw.x) * (acc[cc][4 * g4 + 0] + bsv), bfhi(uw.x) * (acc[cc][4 * g4 + 1] + bsv)); o.y = cvt2(bflo(uw.y) * (acc[cc][4 * g4 + 2] + bsv), bfhi(uw.y) * (acc[cc][4 * g4 + 3] + bsv));
                *(u32x2*)up = o; }
    }
    __syncthreads();
}

namespace gla {
constexpr int QP = 272, QOP = 264, JP = 144;
constexpr int OFF_QI = 0, OFF_KI = OFF_QI + 64 * QP, OFF_QO = OFF_KI + 64 * QP, OFF_KST = OFF_QO + 64 * QOP, OFF_VT = OFF_KST + 128 * JP, OFF_PL = OFF_VT + 256 * JP,
              OFF_TOT = OFF_PL + 64 * JP, OFF_DEC = OFF_TOT + 4096, OFF_RED = OFF_DEC + 512, END = OFF_RED + 2048;
static_assert(END <= 131072 && OFF_QO % 16 == 0 && OFF_KST % 16 == 0 && OFF_VT % 16 == 0 && OFF_PL % 16 == 0 && OFF_TOT % 16 == 0, "gla lds map");
}
__device__ __forceinline__ void p4_gla(const Params& p, LAS unsigned char* lds) {
    const int tid = threadIdx.x, lane = tid & 63, wave = __builtin_amdgcn_readfirstlane(tid >> 6), r = lane & 31, hh = lane >> 5;
    unsigned char* ws = p.ws;
    const bf16_t* Q = (const bf16_t*)(ws + WS_Q); const bf16_t* Kb = (const bf16_t*)(ws + WS_K); const bf16_t* VB = (const bf16_t*)(ws + WS_VB); const bf16_t* LA = (const bf16_t*)(ws + WS_LA);
    bf16_t* R = (bf16_t*)(ws + WS_R); const float* hg = p.in[I_BHN];
    const int b = blockIdx.x >> 2, h = blockIdx.x & 3;
    const int kp = lane, jg = wave;
    const int vp = tid & 127, jq = tid >> 7;
    f32x16 X[4];
#pragma unroll
    for (int kt = 0; kt < 4; ++kt)
#pragma unroll
        for (int e = 0; e < 16; ++e) X[kt][e] = 0.f;
    f32x4 hgv[4];
#pragma unroll
    for (int g4 = 0; g4 < 4; ++g4) hgv[g4] = *(const f32x4*)(hg + h * 256 + 32 * wave + 8 * g4 + 4 * hh);
    unsigned qw[8], kw[8], lw[8], vw[16];
    const size_t rowb = (size_t)b * SEQ;
#define GLA_LOAD_RAW(n) do { \
        _Pragma("unroll") for (int jj = 0; jj < 8; ++jj) { const size_t row = rowb + 64 * (n) + 8 * jg + jj; \
            qw[jj] = *(const unsigned*)(Q + row * 512 + h * 128 + 2 * kp); kw[jj] = *(const unsigned*)(Kb + row * 512 + h * 128 + 2 * kp); lw[jj] = *(const unsigned*)(LA + row * 512 + h * 128 + 2 * kp); } \
        _Pragma("unroll") for (int jj = 0; jj < 16; ++jj) { const size_t row = rowb + 64 * (n) + 16 * jq + jj; vw[jj] = *(const unsigned*)(VB + row * 1024 + h * 256 + 2 * vp); } } while (0)
    GLA_LOAD_RAW(0);
    for (int n = 0; n < SEQ / 64; ++n) {
        {
            float c0[8], c1[8]; float run0 = 0.f, run1 = 0.f;
#pragma unroll
            for (int jj = 0; jj < 8; ++jj) { run0 += bflo(lw[jj]); run1 += bfhi(lw[jj]); c0[jj] = run0; c1[jj] = run1; }
            *(LAS f32x2*)(lds + gla::OFF_TOT + (jg * 128 + 2 * kp) * 4) = (f32x2){run0, run1};
            {
                u32x4 lo0, lo1, hi0, hi1;
#pragma unroll
                for (int m = 0; m < 4; ++m) { lo0[m] = (vw[2 * m] & 0xffffu) | (vw[2 * m + 1] << 16); hi0[m] = (vw[2 * m] >> 16) | (vw[2 * m + 1] & 0xffff0000u);
                                              lo1[m] = (vw[8 + 2 * m] & 0xffffu) | (vw[8 + 2 * m + 1] << 16); hi1[m] = (vw[8 + 2 * m] >> 16) | (vw[8 + 2 * m + 1] & 0xffff0000u); }
                LAS unsigned char* v0 = lds + gla::OFF_VT + (2 * vp) * gla::JP + 2 * (16 * jq); LAS unsigned char* v1 = v0 + gla::JP;
                *(LAS u32x4*)v0 = lo0; *(LAS u32x4*)(v0 + 16) = lo1; *(LAS u32x4*)v1 = hi0; *(LAS u32x4*)(v1 + 16) = hi1;
            }
            __syncthreads();
            f32x2 pre = {0.f, 0.f}, mid = {0.f, 0.f}, last = {0.f, 0.f};
#pragma unroll
            for (int g = 0; g < 8; ++g) { const f32x2 t = *(const LAS f32x2*)(lds + gla::OFF_TOT + (g * 128 + 2 * kp) * 4); if (g < jg) pre += t; if (g < 4) mid += t; last += t; }
            const float EM0 = __expf(mid.x), EM1 = __expf(mid.y), EL0 = __expf(last.x - mid.x), EL1 = __expf(last.y - mid.y);
            if (jg == 0) *(LAS f32x2*)(lds + gla::OFF_DEC + 2 * kp * 4) = (f32x2){__expf(last.x), __expf(last.y)};
            f32x8 ks0, ks1;
#pragma unroll
            for (int jj = 0; jj < 8; ++jj) {
                const float e0 = __expf(pre.x + c0[jj] - mid.x), e1 = __expf(pre.y + c1[jj] - mid.y), r0 = __builtin_amdgcn_rcpf(e0), r1 = __builtin_amdgcn_rcpf(e1);
                const float qi0 = bflo(qw[jj]) * e0, qi1 = bfhi(qw[jj]) * e1, ki0 = bflo(kw[jj]) * r0, ki1 = bfhi(kw[jj]) * r1;
                const int row = 8 * jg + jj;
                *(LAS unsigned*)(lds + gla::OFF_QI + row * gla::QP + 4 * kp) = cvt2(qi0, qi1);
                *(LAS unsigned*)(lds + gla::OFF_KI + row * gla::QP + 4 * kp) = cvt2(ki0, ki1);
                *(LAS unsigned*)(lds + gla::OFF_QO + row * gla::QOP + 4 * kp) = cvt2(qi0 * EM0, qi1 * EM1);
                ks0[jj] = ki0 * EL0; ks1[jj] = ki1 * EL1;
            }
            *(LAS bf16x8*)(lds + gla::OFF_KST + (2 * kp) * gla::JP + 16 * jg) = cvt8(ks0);
            *(LAS bf16x8*)(lds + gla::OFF_KST + (2 * kp + 1) * gla::JP + 16 * jg) = cvt8(ks1);
        }
        if (n + 1 < SEQ / 64) GLA_LOAD_RAW(n + 1);
        __syncthreads();
#pragma unroll
        for (int tt = 0; tt < 2; ++tt) { const int t = 2 * wave + tt, jt = t >> 2, it = t & 3; f32x4 acc = {0.f, 0.f, 0.f, 0.f};
#pragma unroll
            for (int ks = 0; ks < 4; ++ks) { const bf16x8 A = *(const LAS bf16x8*)(lds + gla::OFF_KI + (16 * jt + (lane & 15)) * gla::QP + 2 * (32 * ks + 8 * (lane >> 4)));
                const bf16x8 B = *(const LAS bf16x8*)(lds + gla::OFF_QI + (16 * it + (lane & 15)) * gla::QP + 2 * (32 * ks + 8 * (lane >> 4)));
                acc = __builtin_amdgcn_mfma_f32_16x16x32_bf16(A, B, acc, 0, 0, 0); }
            const int i = 16 * it + (lane & 15), j0 = 16 * jt + 4 * (lane >> 4);
            u32x2 o; o.x = cvt2(j0 <= i ? acc[0] : 0.f, j0 + 1 <= i ? acc[1] : 0.f); o.y = cvt2(j0 + 2 <= i ? acc[2] : 0.f, j0 + 3 <= i ? acc[3] : 0.f);
            *(LAS u32x2*)(lds + gla::OFF_PL + i * gla::JP + 2 * j0) = o; }
        __syncthreads();
        f32x16 oT[2];
#pragma unroll
        for (int it2 = 0; it2 < 2; ++it2)
#pragma unroll
            for (int e = 0; e < 16; ++e) oT[it2][e] = 0.f;
        const LAS unsigned char* vrow = lds + gla::OFF_VT + (32 * wave + r) * gla::JP + 16 * hh;
#pragma unroll
        for (int it2 = 0; it2 < 2; ++it2)
#pragma unroll
            for (int ks = 0; ks < 4; ++ks) { if (it2 == 0 && ks >= 2) continue;
                const bf16x8 A = *(const LAS bf16x8*)(vrow + 32 * ks); const bf16x8 B = *(const LAS bf16x8*)(lds + gla::OFF_PL + (32 * it2 + r) * gla::JP + 32 * ks + 16 * hh);
                oT[it2] = __builtin_amdgcn_mfma_f32_32x32x16_bf16(A, B, oT[it2], 0, 0, 0); }
#pragma unroll
        for (int kt = 0; kt < 4; ++kt)
#pragma unroll
            for (int s = 0; s < 2; ++s) { f32x8 xs;
#pragma unroll
                for (int e = 0; e < 8; ++e) xs[e] = X[kt][8 * s + e];
                const bf16x8 A = cvt8(xs);
#pragma unroll
                for (int it2 = 0; it2 < 2; ++it2) { const LAS unsigned char* qp = lds + gla::OFF_QO + (32 * it2 + r) * gla::QOP + 2 * (32 * kt + 16 * s + 4 * hh);
                    const u32x2 b0 = *(const LAS u32x2*)qp, b1 = *(const LAS u32x2*)(qp + 16); const u32x4 bw = {b0.x, b0.y, b1.x, b1.y};
                    oT[it2] = __builtin_amdgcn_mfma_f32_32x32x16_bf16(A, __builtin_bit_cast(bf16x8, bw), oT[it2], 0, 0, 0); } }
#pragma unroll
        for (int kt = 0; kt < 4; ++kt) {
#pragma unroll
            for (int g4 = 0; g4 < 4; ++g4) { const f32x4 dv = *(const LAS f32x4*)(lds + gla::OFF_DEC + (32 * kt + 8 * g4 + 4 * hh) * 4);
#pragma unroll
                for (int e = 0; e < 4; ++e) X[kt][4 * g4 + e] *= dv[e]; }
#pragma unroll
            for (int ks = 0; ks < 4; ++ks) { const bf16x8 A = *(const LAS bf16x8*)(lds + gla::OFF_KST + (32 * kt + r) * gla::JP + 32 * ks + 16 * hh); const bf16x8 B = *(const LAS bf16x8*)(vrow + 32 * ks);
                X[kt] = __builtin_amdgcn_mfma_f32_32x32x16_bf16(A, B, X[kt], 0, 0, 0); } }
#pragma unroll
        for (int it2 = 0; it2 < 2; ++it2) { float ss = 0.f;
#pragma unroll
            for (int e = 0; e < 16; ++e) ss += oT[it2][e] * oT[it2][e];
            ss += __shfl_xor(ss, 32);
            if (hh == 0) *(LAS float*)(lds + gla::OFF_RED + ((32 * it2 + r) * 8 + wave) * 4) = ss; }
        __syncthreads();
#pragma unroll
        for (int it2 = 0; it2 < 2; ++it2) { const f32x4 s0 = *(const LAS f32x4*)(lds + gla::OFF_RED + (32 * it2 + r) * 32), s1 = *(const LAS f32x4*)(lds + gla::OFF_RED + (32 * it2 + r) * 32 + 16);
            const float rs = 1.0f / sqrtf(((s0[0] + s0[1]) + (s0[2] + s0[3]) + (s1[0] + s1[1]) + (s1[2] + s1[3])) * (1.0f / 256.0f) + EPS);
            bf16_t* rp = R + (rowb + 64 * n + 32 * it2 + r) * 1024 + h * 256 + 32 * wave + 4 * hh;
#pragma unroll
            for (int g4 = 0; g4 < 4; ++g4) { const u32x2 rw = *(const u32x2*)(rp + 8 * g4); u32x2 o;
                o.x = cvt2(oT[it2][4 * g4 + 0] * rs * hgv[g4][0] * bflo(rw.x), oT[it2][4 * g4 + 1] * rs * hgv[g4][1] * bfhi(rw.x));
                o.y = cvt2(oT[it2][4 * g4 + 2] * rs * hgv[g4][2] * bflo(rw.y), oT[it2][4 * g4 + 3] * rs * hgv[g4][3] * bfhi(rw.y));
                *(u32x2*)(rp + 8 * g4) = o; } }
        __syncthreads();
    }
#undef GLA_LOAD_RAW
}

__device__ __forceinline__ void p9_final(const Params& p) {
    const int tid = threadIdx.x, lane = tid & 63, wave = tid >> 6;
    const int gw = blockIdx.x * 8 + wave, NGW = gridDim.x * 8;
    const f32x4* gr = (const f32x4*)(p.in[I_FINN]) + lane;
    for (int m = gw; m < T; m += NGW) { f32x4* xr = (f32x4*)(p.out + (size_t)m * D) + lane; f32x4 v[4]; float s = 0.f;
#pragma unroll
        for (int j = 0; j < 4; ++j) { v[j] = xr[64 * j]; s += (v[j][0] * v[j][0] + v[j][1] * v[j][1]) + (v[j][2] * v[j][2] + v[j][3] * v[j][3]); }
        const float rs = 1.0f / sqrtf(wave_sum(s) * (1.0f / D) + EPS);
#pragma unroll
        for (int j = 0; j < 4; ++j) xr[64 * j] = v[j] * rs * gr[64 * j]; }
}

__global__ void __launch_bounds__(NTHREADS, 2) mega_fwd(Params p) {
    extern __shared__ __attribute__((aligned(16))) unsigned char lds_raw[];
    LAS unsigned char* lds = (LAS unsigned char*)lds_raw;
    cg::grid_group grid = cg::this_grid();
    unsigned char* ws = p.ws;
    const int G = gridDim.x, c = blockIdx.x;
    const int lo = p.ph_lo, hi = p.ph_hi;
#define IN(k) (lo <= (k) && (k) < hi)
#define SEAM(k) do { if (IN(k) && IN((k) + 1)) grid.sync(); } while (0)
    if (IN(0)) p0_prep(p, lds);
    SEAM(0);
    if (IN(1)) {
        pg8::Gemm g{(const bf16_t*)(ws + WS_XB), nullptr, (const bf16_t*)(ws + WS_W1IN), nullptr, D, D, D, 1}; pg8::Order S; S.init(T, 2 * DFF, G, c, 1);
        pg8::EpiSwiGLU E{(const float*)(ws + WS_RS0), nullptr, (bf16_t*)(ws + WS_H)};
        pg8::gemm_phase(lds, g, S, E);
    }
    SEAM(1);
    if (IN(2)) {
        pg8::Gemm g{(const bf16_t*)(ws + WS_H), nullptr, (const bf16_t*)(ws + WS_W1OUT), nullptr, DFF, DFF, DFF, 1}; pg8::Order S; S.init(T, D, G, c, 1);
        pg8::EpiResid<false, false, true> E{p.in[I_X], 0.5f, nullptr, (bf16_t*)(ws + WS_XB), (float*)(ws + WS_SSQ1)};
        pg8::gemm_phase(lds, g, S, E);
    }
    SEAM(2);
    if (IN(3)) {
        pg8::Gemm g{(const bf16_t*)(ws + WS_XB), nullptr, (const bf16_t*)(ws + WS_WIN), nullptr, D, D, D, 1}; pg8::Order S; S.init(T, NWIN, G, c, 1);
        pg8::EpiWin E{(const float*)(ws + WS_SSQ1), (bf16_t*)(ws + WS_U), (bf16_t*)(ws + WS_V), (bf16_t*)(ws + WS_Q), (bf16_t*)(ws + WS_K), (bf16_t*)(ws + WS_VB), (bf16_t*)(ws + WS_R), (bf16_t*)p.out, (bf16_t*)(ws + WS_LA),
                      (float*)(ws + WS_LNST), p.in[I_BGATE], p.in[I_BBA]};
        pg8::gemm_phase(lds, g, S, E);
    }
    SEAM(3);
    if (IN(4)) {
#if defined(MIX_SIMPLE)
        p4_gla_simple(p, lds); __syncthreads(); p4_gmlp_simple(p, lds);
#else
        if (blockIdx.x < 32) p4_gla(p, lds); else p4_gmlp(p, lds, 32);
#endif
    }
    SEAM(4);
    if (IN(5)) {
        pg8::Gemm g{(const bf16_t*)(ws + WS_U), (const bf16_t*)(ws + WS_R), (const bf16_t*)(ws + WS_WPA), (const bf16_t*)(ws + WS_WPB), D, D, D, 1}; pg8::Order S; S.init(T, D, G, c, 2);
        pg8::EpiProj E{(const bf16_t*)p.out, (bf16_t*)(ws + WS_V)};
        pg8::gemm_phase(lds, g, S, E);
    }
    SEAM(5);
    if (IN(6)) {
        pg8::Gemm g{(const bf16_t*)(ws + WS_V), nullptr, (const bf16_t*)(ws + WS_WO), nullptr, D, D, D, 1}; pg8::Order S; S.init(T, D, G, c, 1);
        pg8::EpiResid<true, true, true> E{(const void*)(ws + WS_XB), 1.0f, (float*)(ws + WS_X2), (bf16_t*)(ws + WS_X2B), (float*)(ws + WS_SSQ2)};
        pg8::gemm_phase(lds, g, S, E);
    }
    SEAM(6);
    if (IN(7)) {
        pg8::Gemm g{(const bf16_t*)(ws + WS_X2B), nullptr, (const bf16_t*)(ws + WS_W2IN), nullptr, D, D, D, 1}; pg8::Order S; S.init(T, 2 * DFF, G, c, 1);
        pg8::EpiSwiGLU E{nullptr, (const float*)(ws + WS_SSQ2), (bf16_t*)(ws + WS_H2)};
        pg8::gemm_phase(lds, g, S, E);
    }
    SEAM(7);
    if (IN(8)) {
        pg8::Gemm g{(const bf16_t*)(ws + WS_H2), nullptr, (const bf16_t*)(ws + WS_W2OUT), nullptr, DFF, DFF, DFF, 1}; pg8::Order S; S.init(T, D, G, c, 1);
        pg8::EpiResid<false, true, false> E{(const void*)(ws + WS_X2), 0.5f, p.out, nullptr, nullptr};
        pg8::gemm_phase(lds, g, S, E);
    }
    SEAM(8);
    if (IN(9)) p9_final(p);
#undef IN
#undef SEAM
}

extern "C" void kernel_launch(void* const* d_in, const int* in_sizes, int n_in, void* d_out, int out_size, void* d_ws, size_t ws_size, hipStream_t stream) {
    static int grid = 0;
    if (grid == 0) {
        int dev = 0, cus = 0, per_cu = 0;
        (void)hipGetDevice(&dev);
        (void)hipDeviceGetAttribute(&cus, hipDeviceAttributeMultiprocessorCount, dev);
        (void)hipFuncSetAttribute((const void*)mega_fwd, hipFuncAttributeMaxDynamicSharedMemorySize, LDS_BYTES);
        (void)hipOccupancyMaxActiveBlocksPerMultiprocessor(&per_cu, (const void*)mega_fwd, NTHREADS, LDS_BYTES);
        if (per_cu < 1) { fprintf(stderr, "kernel_launch: occupancy query says %d blocks/CU\n", per_cu); per_cu = 1; }
        grid = cus;
        if (n_in != 21 || out_size != T * D || ws_size < WS_END) fprintf(stderr, "kernel_launch: unexpected sizes n_in %d out %d ws %zu\n", n_in, out_size, ws_size);
        fprintf(stderr, "kernel_launch: cus %d per_cu %d grid %d ws %zu\n", cus, per_cu, grid, ws_size);
    }
    Params p{};
    for (int i = 0; i < 21; ++i) p.in[i] = (const float*)d_in[i];
    p.out = (float*)d_out; p.ws = (unsigned char*)d_ws; p.ph_lo = 0; p.ph_hi = 10;
    void* args[] = {&p};
    hipError_t e = hipLaunchCooperativeKernel((const void*)mega_fwd, dim3(grid), dim3(NTHREADS), args, LDS_BYTES, stream);
    if (e != hipSuccess) fprintf(stderr, "cooperative launch failed: %s (grid %d)\n", hipGetErrorString(e), grid);
}
```

```cpp
#include <hip/hip_runtime.h>
#include <hip/hip_cooperative_groups.h>
#include <cstdio>
#include <cstdint>
namespace cg = cooperative_groups;

#define LAS __attribute__((address_space(3)))
typedef unsigned short bf16_t;
typedef short bf16x8 __attribute__((ext_vector_type(8)));
typedef float f32x4 __attribute__((ext_vector_type(4)));
typedef float f32x2 __attribute__((ext_vector_type(2)));
typedef unsigned u32x4 __attribute__((ext_vector_type(4)));
typedef unsigned u32x2 __attribute__((ext_vector_type(2)));
typedef float f32x8 __attribute__((ext_vector_type(8)));
typedef float f32x16 __attribute__((ext_vector_type(16)));
typedef __bf16 bf16x8_t __attribute__((ext_vector_type(8)));
typedef __bf16 bf16x2_t __attribute__((ext_vector_type(2)));

constexpr int T = 65536, D = 1024, DFF = 2816, SEQ = 8192;
constexpr int NWIN = 7680;
constexpr float EPS = 1e-6f;
constexpr int NTHREADS = 512;
constexpr int LDS_BYTES = 147456;

constexpr size_t MiB = (size_t)1 << 20;
constexpr size_t WS_GQ = 128;
constexpr size_t WS_XBAR = 64 * 1024;
constexpr size_t WS_RS0 = 1 * MiB;
constexpr size_t WS_SSQ1 = 2 * MiB;
constexpr size_t WS_SSQ2 = 6 * MiB;
constexpr size_t WS_LNST = 10 * MiB;
constexpr size_t WS_W1IN = 20 * MiB, WS_W1OUT = 31 * MiB, WS_WIN = 37 * MiB, WS_WPA = 52 * MiB, WS_WPB = 54 * MiB, WS_WO = 56 * MiB, WS_W2IN = 58 * MiB, WS_W2OUT = 69 * MiB;
constexpr size_t ACT0 = 76 * MiB;
constexpr size_t WS_XB = ACT0;
constexpr size_t WS_H = ACT0 + 128 * MiB;
constexpr size_t WS_U = ACT0 + 128 * MiB;
constexpr size_t WS_V = ACT0 + 256 * MiB;
constexpr size_t WS_Q = ACT0 + 384 * MiB;
constexpr size_t WS_K = ACT0 + 448 * MiB;
constexpr size_t WS_VB = ACT0 + 512 * MiB;
constexpr size_t WS_R = ACT0 + 640 * MiB;
constexpr size_t WS_LA = ACT0 + 768 * MiB;
constexpr size_t WS_X2B = ACT0 + 128 * MiB;
constexpr size_t WS_H2 = ACT0 + 256 * MiB;
constexpr size_t WS_GLAE = ACT0 + 832 * MiB;
constexpr size_t WS_GLAD = ACT0 + 864 * MiB;
constexpr size_t WS_END = ACT0 + 896 * MiB;
static_assert(WS_END <= 1024 * MiB, "ws map");

__device__ __forceinline__ unsigned f2bf(float f) { unsigned u = __builtin_bit_cast(unsigned, f); return (u + 0x7fffu + ((u >> 16) & 1u)) >> 16; }
__device__ __forceinline__ unsigned pk2(float lo, float hi) { return f2bf(lo) | (f2bf(hi) << 16); }
__device__ __forceinline__ float bf2f(unsigned short b) { return __builtin_bit_cast(float, ((unsigned)b) << 16); }
__device__ __forceinline__ float bflo(unsigned w) { return __builtin_bit_cast(float, w << 16); }
__device__ __forceinline__ float bfhi(unsigned w) { return __builtin_bit_cast(float, w & 0xffff0000u); }
__device__ __forceinline__ float wave_sum(float v) {
#pragma unroll
    for (int o = 1; o < 64; o <<= 1) v += __shfl_xor(v, o);
    return v;
}

__device__ __forceinline__ bf16x8 cvt8(f32x8 v) { return __builtin_bit_cast(bf16x8, __builtin_convertvector(v, bf16x8_t)); }
__device__ __forceinline__ unsigned cvt2(float a, float b) { const f32x2 v = {a, b}; return __builtin_bit_cast(unsigned, __builtin_convertvector(v, bf16x2_t)); }

namespace pg8 {
constexpr int BM = 256, BK = 64, HALF = 128, HTB = HALF * BK * 2, STAGE_BYTES = 8 * HTB, NXCD = 8, WGM = 8;
__host__ __device__ __forceinline__ int lds_byte(int r, int c) { const int st = (r >> 4) * 2 + (c >> 5), rr = r & 15, cc = c & 31, ob = rr * 64 + cc * 2; return st * 1024 + (ob ^ (((ob >> 9) & 1) << 5)); }
__host__ __device__ __forceinline__ void stage_rc(int b, int& R, int& C) { const int st = b / 1024, sb = b % 1024, swz = sb ^ (((sb >> 9) & 1) << 5); R = (st >> 1) * 16 + swz / 64; C = (st & 1) * 32 + (swz % 64) / 2; }
__host__ __device__ __forceinline__ int perm32(int rho) { const int n = rho >> 4, i = rho & 15; return 8 * (i >> 2) + 4 * n + (i & 3); }

struct Unit { int pm, pn, seg; };
struct Gemm { const bf16_t *A0, *A1, *B0, *B1; int lda, ldb, K, nsh; };
__device__ __forceinline__ const char* a_ptr(const Gemm& g, const Unit& u) { const bool s = u.seg >= g.nsh; const bf16_t* b = s ? g.A1 : g.A0; const int ks = s ? u.seg - g.nsh : u.seg; return (const char*)(b + (size_t)u.pm * BM * g.lda + ks * g.K); }
__device__ __forceinline__ const char* b_ptr(const Gemm& g, const Unit& u) { const bool s = u.seg >= g.nsh; const bf16_t* b = s ? g.B1 : g.B0; const int ks = s ? u.seg - g.nsh : u.seg; return (const char*)(b + (size_t)u.pn * BM * g.ldb + ks * g.K); }

struct Order {
    int nM, nN, nwg, G, c, nseg, nper, revn;
    __device__ void init(int M, int N, int G_, int c_, int nseg_, bool rev = false, bool revn_ = false) { nM = M / BM; nN = N / BM; nwg = nM * nN; G = G_; c = c_; nseg = nseg_; nper = rev ? (nwg - c + G - 1) / G : 0; revn = revn_ ? 1 : 0; }
    __device__ bool next(int i, Unit& u) const {
        int ti = i / nseg; u.seg = i - ti * nseg;
        if (nper > 0) { if (ti >= nper) return false; ti = nper - 1 - ti; }
        const long L = (long)ti * G + c; if (L >= nwg) return false;
        int wgid = (int)L; { const int q = nwg / NXCD, r = nwg % NXCD, xcd = wgid % NXCD, off = wgid / NXCD; wgid = (xcd < r ? xcd * (q + 1) : r * (q + 1) + (xcd - r) * q) + off; }
        const int nig = WGM * nN, gid = wgid / nig, fm = gid * WGM, gsz = (nM - fm) < WGM ? (nM - fm) : WGM;
        u.pm = fm + ((wgid % nig) % gsz); u.pn = (wgid % nig) / gsz; if (revn) u.pn = nN - 1 - u.pn; return true;
    }
};

__device__ __forceinline__ unsigned cvt_pk_bf16(float lo, float hi) { unsigned r; asm volatile("v_cvt_pk_bf16_f32 %0, %1, %2" : "=v"(r) : "v"(lo), "v"(hi)); return r; }
__device__ __forceinline__ f32x2 gelu_pk(f32x2 v) {
    const f32x2 av = __builtin_elementwise_abs(v), d = av * 0.2316418882f + 1.0f;
    f32x2 t; t.x = __builtin_amdgcn_rcpf(d.x); t.y = __builtin_amdgcn_rcpf(d.y);
    f32x2 q = t * 0.5307027145f + (-0.7265760135f); q = q * t + 0.7107068705f; q = q * t + (-0.142248368f); q = q * t + 0.127414796f; q = q * t;
    const f32x2 s = (v * v) * (-0.72134752044f);
    f32x2 e; e.x = __builtin_amdgcn_exp2f(s.x); e.y = __builtin_amdgcn_exp2f(s.y);
    const f32x2 m = v * (q * e), r = v - m;
    f32x2 o; o.x = v.x < 0.f ? m.x : r.x; o.y = v.y < 0.f ? m.y : r.y; return o;
}
__device__ __forceinline__ f32x4 gelu4(f32x4 v) { const f32x2 a = gelu_pk((f32x2){v[0], v[1]}), b = gelu_pk((f32x2){v[2], v[3]}); return (f32x4){a.x, a.y, b.x, b.y}; }
__device__ __forceinline__ f32x4 ex2n4(f32x4 v) { const f32x4 t = v * (-1.4426950408889634f); return (f32x4){__builtin_amdgcn_exp2f(t[0]), __builtin_amdgcn_exp2f(t[1]), __builtin_amdgcn_exp2f(t[2]), __builtin_amdgcn_exp2f(t[3])}; }
__device__ __forceinline__ f32x4 rcp4(f32x4 v) { return (f32x4){__builtin_amdgcn_rcpf(v[0]), __builtin_amdgcn_rcpf(v[1]), __builtin_amdgcn_rcpf(v[2]), __builtin_amdgcn_rcpf(v[3])}; }
__device__ __forceinline__ f32x4 sigm4(f32x4 v) { return rcp4(ex2n4(v) + 1.0f); }
__device__ __forceinline__ f32x4 silu4(f32x4 v) { return v * sigm4(v); }
__device__ __forceinline__ f32x4 lsig4(f32x4 v) {
    const f32x4 e = ex2n4(__builtin_elementwise_abs(v)) + 1.0f;
    const f32x4 l = {__builtin_amdgcn_logf(e[0]), __builtin_amdgcn_logf(e[1]), __builtin_amdgcn_logf(e[2]), __builtin_amdgcn_logf(e[3])};
    return (__builtin_elementwise_min(v, (f32x4){0.f, 0.f, 0.f, 0.f}) * 1.4426950408889634f - l) * 0.0625f;
}
__device__ __forceinline__ u32x4 pack8(f32x4 v0, f32x4 v1) { u32x4 w; w.x = cvt_pk_bf16(v0[0], v0[1]); w.y = cvt_pk_bf16(v0[2], v0[3]); w.z = cvt_pk_bf16(v1[0], v1[1]); w.w = cvt_pk_bf16(v1[2], v1[3]); return w; }
__device__ __forceinline__ void unpack8(u32x4 w, f32x4& v0, f32x4& v1) { v0 = (f32x4){bflo(w.x), bfhi(w.x), bflo(w.y), bfhi(w.y)}; v1 = (f32x4){bflo(w.z), bfhi(w.z), bflo(w.w), bfhi(w.w)}; }
__device__ __forceinline__ void rows_rs16(const float* ssq, int row0, int fq, float sc, float (&rsv)[2][4]) {
    f32x4 sv[2][4];
#pragma unroll
    for (int ai = 0; ai < 2; ++ai)
#pragma unroll
        for (int m = 0; m < 4; ++m) sv[ai][m] = *(const f32x4*)(ssq + (size_t)(row0 + ai * 128 + m * 16) * 16 + 4 * fq);
#pragma unroll
    for (int ai = 0; ai < 2; ++ai)
#pragma unroll
        for (int m = 0; m < 4; ++m) { float s = (sv[ai][m][0] + sv[ai][m][1]) + (sv[ai][m][2] + sv[ai][m][3]);
            s += __shfl_xor(s, 16); s += __shfl_xor(s, 32);
            rsv[ai][m] = __builtin_amdgcn_rsqf(s * (1.0f / 1024.0f) + EPS) * sc; }
}

__device__ __forceinline__ void rs_table_fill(LAS float* tab, const float* direct, const float* ssq, int pm, int tid) {
    const int row = tid >> 1, half = tid & 1; const size_t grow = (size_t)pm * 256 + row;
    if (direct) { if (half == 0) tab[row] = direct[grow]; }
    else { const f32x4 v0 = *(const f32x4*)(ssq + grow * 16 + 8 * half), v1 = *(const f32x4*)(ssq + grow * 16 + 8 * half + 4);
        float t = ((v0[0] + v0[1]) + (v0[2] + v0[3])) + ((v1[0] + v1[1]) + (v1[2] + v1[3])); t += __shfl_xor(t, 1);
        if (half == 0) tab[row] = __builtin_amdgcn_rsqf(t * (1.0f / 1024.0f) + EPS); }
}

typedef f32x4 Acc[2][2][4][2];

struct EpiSwiGLU {
    const float* rs_direct;
    const float* ssq;
    bf16_t* H;
    __device__ __forceinline__ bool keep(const Unit&) const { return false; }
    static constexpr bool USES_RS = true;
    __device__ __forceinline__ void run_rs(Acc& acc, const Unit& u, int wr, int wc, int fr, int fq, const LAS float* rs_tab) const {
        const int row0 = u.pm * BM + wr * 64 + fr, col0 = u.pn * 128 + wc * 32 + 8 * fq;
        float rsv[2][4];
#pragma unroll
        for (int ai = 0; ai < 2; ++ai)
#pragma unroll
            for (int m = 0; m < 4; ++m) rsv[ai][m] = rs_tab[ai * HALF + wr * 64 + m * 16 + fr];
#pragma unroll
        for (int ai = 0; ai < 2; ++ai)
#pragma unroll
            for (int m = 0; m < 4; ++m) { const int row = row0 + ai * HALF + m * 16;
                const float rs = rsv[ai][m];
                const f32x4 a0 = acc[ai][0][m][0] * rs, a1 = acc[ai][0][m][1] * rs, b0 = acc[ai][1][m][0] * rs, b1 = acc[ai][1][m][1] * rs;
                *(u32x4*)(H + (size_t)row * DFF + col0) = pack8(silu4(a0) * b0, silu4(a1) * b1); }
    }
};
template <bool OUT_F32, bool OUT_BF16> struct EpiResid {
    static constexpr bool USES_RS = false;
    const bf16_t* base; float scale; float* of32; bf16_t* obf; float* ssq;
    __device__ __forceinline__ bool keep(const Unit&) const { return false; }
    __device__ __forceinline__ void operator()(Acc& acc, const Unit& u, int wr, int wc, int fr, int fq) const {
        const int row0 = u.pm * BM + wr * 64 + fr, col0 = u.pn * BM + wc * 32 + 8 * fq;
        u32x4 bw[2][4][2];
#pragma unroll
        for (int ai = 0; ai < 2; ++ai)
#pragma unroll
            for (int m = 0; m < 4; ++m)
#pragma unroll
                for (int bj = 0; bj < 2; ++bj) bw[ai][m][bj] = *(const u32x4*)(base + (size_t)(row0 + ai * HALF + m * 16) * D + col0 + bj * HALF);
#pragma unroll
        for (int ai = 0; ai < 2; ++ai)
#pragma unroll
            for (int m = 0; m < 4; ++m) { const int row = row0 + ai * HALF + m * 16; const size_t off = (size_t)row * D + col0; float q = 0.f;
#pragma unroll
                for (int bj = 0; bj < 2; ++bj) { f32x4 b0, b1; unpack8(bw[ai][m][bj], b0, b1);
                    const f32x4 v0 = b0 + acc[ai][bj][m][0] * scale, v1 = b1 + acc[ai][bj][m][1] * scale;
                    q += (v0[0] * v0[0] + v0[1] * v0[1]) + (v0[2] * v0[2] + v0[3] * v0[3]) + (v1[0] * v1[0] + v1[1] * v1[1]) + (v1[2] * v1[2] + v1[3] * v1[3]);
                    if (OUT_F32) { *(f32x4*)(of32 + off + bj * HALF) = v0; *(f32x4*)(of32 + off + bj * HALF + 4) = v1; }
                    if (OUT_BF16) *(u32x4*)(obf + off + bj * HALF) = pack8(v0, v1); }
                q += __shfl_xor(q, 16); q += __shfl_xor(q, 32);
                if (ssq && fq == 0) ssq[(size_t)row * 16 + 4 * u.pn + wc] = q; }
    }
};
struct EpiWin {
    const float* ssq; bf16_t *U, *V, *Q, *Kb, *VB, *R, *G, *LA; float* lnst; const float *b_gate, *b_alpha;
    __device__ __forceinline__ bool keep(const Unit&) const { return false; }
    static constexpr bool USES_RS = true; static constexpr const float* rs_direct = nullptr;
    __device__ __forceinline__ void run_rs(Acc& acc, const Unit& u, int wr, int wc, int fr, int fq, const LAS float* rs_tab) const {
        const int pn = u.pn; int kind, ld, colt; bf16_t* basep; const float* bias = nullptr; float sc = 1.f; bool stats = false;
        if (pn < 4) { kind = 1; basep = U; ld = 1024; colt = 256 * pn; }
        else if (pn < 8) { kind = 1; basep = V; ld = 1024; colt = 256 * (pn - 4); stats = true; }
        else if (pn < 10) { kind = 0; basep = Q; ld = 512; colt = 256 * (pn - 8); sc = 0.08838834764831845f; }
        else if (pn < 12) { kind = 0; basep = Kb; ld = 512; colt = 256 * (pn - 10); }
        else if (pn < 16) { kind = 0; basep = VB; ld = 1024; colt = 256 * (pn - 12); }
        else if (pn < 20) { kind = 2; basep = R; ld = 1024; colt = 256 * (pn - 16); }
        else if (pn < 28) { kind = 3; basep = G; ld = 2048; colt = 256 * (pn - 20); bias = b_gate; }
        else { kind = 4; basep = LA; ld = 512; colt = 256 * (pn - 28); bias = b_alpha; }
        const int row0 = u.pm * BM + wr * 64 + fr, col0 = colt + wc * 32 + 8 * fq;
        f32x4 bv[2][2];
        if (bias) {
#pragma unroll
            for (int bj = 0; bj < 2; ++bj)
#pragma unroll
                for (int n = 0; n < 2; ++n) bv[bj][n] = *(const f32x4*)(bias + col0 + bj * HALF + 4 * n); }
        float rsv[2][4];
#pragma unroll
        for (int ai = 0; ai < 2; ++ai)
#pragma unroll
            for (int m = 0; m < 4; ++m) rsv[ai][m] = rs_tab[ai * HALF + wr * 64 + m * 16 + fr] * sc;
#pragma unroll
        for (int ai = 0; ai < 2; ++ai)
#pragma unroll
            for (int m = 0; m < 4; ++m) { const int row = row0 + ai * HALF + m * 16; const float rs = rsv[ai][m]; float s1 = 0.f, s2 = 0.f;
                bf16_t* rowp = basep + (size_t)row * ld + col0;
#pragma unroll
                for (int bj = 0; bj < 2; ++bj) { f32x4 v0 = acc[ai][bj][m][0] * rs, v1 = acc[ai][bj][m][1] * rs;
                    if (bias) { v0 += bv[bj][0]; v1 += bv[bj][1]; }
                    if (kind == 1) { v0 = gelu4(v0); v1 = gelu4(v1); }
                    else if (kind == 2) { v0 = silu4(v0); v1 = silu4(v1); }
                    else if (kind == 3) { v0 = sigm4(v0); v1 = sigm4(v1); }
                    else if (kind == 4) { v0 = lsig4(v0); v1 = lsig4(v1); }
                    if (stats) { s1 += (v0[0] + v0[1]) + (v0[2] + v0[3]) + (v1[0] + v1[1]) + (v1[2] + v1[3]);
                        s2 += (v0[0] * v0[0] + v0[1] * v0[1]) + (v0[2] * v0[2] + v0[3] * v0[3]) + (v1[0] * v1[0] + v1[1] * v1[1]) + (v1[2] * v1[2] + v1[3] * v1[3]); }
                    if (pn < 8) *(u32x4*)(rowp + bj * HALF) = pack8(v0, v1); else __builtin_nontemporal_store(pack8(v0, v1), (u32x4*)(rowp + bj * HALF)); }
                if (stats) { s1 += __shfl_xor(s1, 16); s1 += __shfl_xor(s1, 32); s2 += __shfl_xor(s2, 16); s2 += __shfl_xor(s2, 32);
                    if (fq == 0) *(f32x2*)(lnst + ((size_t)row * 16 + 4 * (pn - 4) + wc) * 2) = (f32x2){s1, s2}; } }
    }
};
struct EpiProj {
    static constexpr bool USES_RS = false;
    const bf16_t* G; bf16_t* Mb;
    __device__ __forceinline__ bool keep(const Unit& u) const { return u.seg == 0; }
    __device__ __forceinline__ void operator()(Acc& acc, const Unit& u, int wr, int wc, int fr, int fq) const {
        const int row0 = u.pm * BM + wr * 64 + fr, col0 = u.pn * BM + wc * 32 + 8 * fq;
        if (u.seg == 0) {
#pragma unroll
            for (int ai = 0; ai < 2; ++ai)
#pragma unroll
                for (int m = 0; m < 4; ++m)
#pragma unroll
                    for (int bj = 0; bj < 2; ++bj) { const bf16_t* gp = G + (size_t)(row0 + ai * HALF + m * 16) * 2048 + col0 + bj * HALF;
                        f32x4 sa0, sa1, sb0, sb1; unpack8(*(const u32x4*)gp, sa0, sa1); unpack8(*(const u32x4*)(gp + 1024), sb0, sb1);
#pragma unroll
                        for (int e = 0; e < 4; ++e) { acc[ai][bj][m][0][e] *= sa0[e] * __builtin_amdgcn_rcpf(fmaxf(sb0[e], 1e-30f)); acc[ai][bj][m][1][e] *= sa1[e] * __builtin_amdgcn_rcpf(fmaxf(sb1[e], 1e-30f)); } }
        } else {
            u32x4 gw[2][4][2];
#pragma unroll
            for (int ai = 0; ai < 2; ++ai)
#pragma unroll
                for (int m = 0; m < 4; ++m)
#pragma unroll
                    for (int bj = 0; bj < 2; ++bj) gw[ai][m][bj] = *(const u32x4*)(G + (size_t)(row0 + ai * HALF + m * 16) * 2048 + 1024 + col0 + bj * HALF);
#pragma unroll
            for (int ai = 0; ai < 2; ++ai)
#pragma unroll
                for (int m = 0; m < 4; ++m)
#pragma unroll
                    for (int bj = 0; bj < 2; ++bj) { f32x4 sb0, sb1; unpack8(gw[ai][m][bj], sb0, sb1);
                        *(u32x4*)(Mb + (size_t)(row0 + ai * HALF + m * 16) * D + col0 + bj * HALF) = pack8(acc[ai][bj][m][0] * sb0, acc[ai][bj][m][1] * sb1); }
        }
    }
};

template <class Epi>
__device__ __forceinline__ void gemm_phase(LAS unsigned char* lds, const Gemm g, const Order& S, const Epi& E) {
    const int tid = threadIdx.x, wid = __builtin_amdgcn_readfirstlane(tid >> 6), lane = tid & 63, wr = wid >> 2, wc = wid & 3, fr = lane & 15, fq = lane >> 4;
    const int nt = g.K / BK;
    unsigned voffA[2], voffB[2];
#pragma unroll
    for (int i = 0; i < 2; ++i) { int R, C; stage_rc(tid * 16 + i * 8192, R, C); const int Rb = (R & ~31) + perm32(R & 31);
        voffA[i] = (unsigned)(R * g.lda + C) * 2u; voffB[i] = (unsigned)(Rb * g.ldb + C) * 2u; }
    const size_t kstep = (size_t)(BK * 2);
    const size_t hstepA = (size_t)HALF * g.lda * 2, hstepB = (size_t)HALF * g.ldb * 2;
    const unsigned ldsw = (unsigned)wid * 1024u;
    const int aoff = lds_byte(wr * 64 + fr, fq * 8), boff = lds_byte(wc * 32 + fr, fq * 8);
#define PG8_SA(b, h) (((b) * 2 + (h)) * HTB)
#define PG8_SB(b, h) ((4 + (b) * 2 + (h)) * HTB)
#define PG8_STAGE(bufoff, gbase, voff) do { _Pragma("unroll") for (int _i = 0; _i < 2; ++_i) \
        __builtin_amdgcn_global_load_lds((const unsigned*)((const char*)(gbase) + (voff)[_i]), (LAS unsigned*)(lds + (bufoff) + ldsw + _i * 8192), 16, 0, 0); } while (0)
#define PG8_LDA(dst, b, h) do { _Pragma("unroll") for (int m = 0; m < 4; ++m) _Pragma("unroll") for (int k = 0; k < 2; ++k) dst[m][k] = *(const LAS bf16x8*)(lds + PG8_SA(b, h) + aoff + m * 2048 + k * 1024); } while (0)
#define PG8_LDB(dst, b, h) do { _Pragma("unroll") for (int n = 0; n < 2; ++n) _Pragma("unroll") for (int k = 0; k < 2; ++k) dst[n][k] = *(const LAS bf16x8*)(lds + PG8_SB(b, h) + boff + n * 2048 + k * 1024); } while (0)
#define PG8_MMA(ai, bj, At, Bt) do { __builtin_amdgcn_s_setprio(1); _Pragma("unroll") for (int m = 0; m < 4; ++m) _Pragma("unroll") for (int n = 0; n < 2; ++n) _Pragma("unroll") for (int k = 0; k < 2; ++k) \
        acc[ai][bj][m][n] = __builtin_amdgcn_mfma_f32_16x16x32_bf16(Bt[n][k], At[m][k], acc[ai][bj][m][n], 0, 0, 0); __builtin_amdgcn_s_setprio(0); } while (0)
#define PG8_WAIT_V(n) asm volatile("s_waitcnt vmcnt(" #n ")" ::: "memory")
#define PG8_WAIT_L(n) asm volatile("s_waitcnt lgkmcnt(" #n ")" ::: "memory")
#define PG8_BAR __builtin_amdgcn_s_barrier()
#define PG8_SCHED __builtin_amdgcn_sched_barrier(0)
    Unit cur, nxt; int ui = 0;
    if (!S.next(0, cur)) return;
    Acc acc;
#pragma unroll
    for (int a = 0; a < 2; ++a)
#pragma unroll
        for (int b = 0; b < 2; ++b)
#pragma unroll
            for (int m = 0; m < 4; ++m)
#pragma unroll
                for (int n = 0; n < 2; ++n) acc[a][b][m][n] = (f32x4){0.f, 0.f, 0.f, 0.f};
    bf16x8 At[4][2], B0[2][2], B1[2][2];
    const char* cA = a_ptr(g, cur); const char* cB = b_ptr(g, cur);
    PG8_STAGE(PG8_SB(0, 0), cB, voffB); PG8_STAGE(PG8_SB(0, 1), cB + hstepB, voffB); PG8_STAGE(PG8_SA(0, 0), cA, voffA); PG8_STAGE(PG8_SA(0, 1), cA + hstepA, voffA);
    if (wr == 1) PG8_BAR;
    PG8_WAIT_V(2); PG8_BAR;
    PG8_STAGE(PG8_SB(1, 0), cB + kstep, voffB); PG8_STAGE(PG8_SA(1, 0), cA + kstep, voffA); PG8_STAGE(PG8_SB(1, 1), cB + hstepB + kstep, voffB);
    PG8_WAIT_V(6); PG8_BAR;
    int tab_pm = -1, tab_sel = 0;
    for (;;) {
        if constexpr (Epi::USES_RS) { if (cur.pm != tab_pm) { tab_pm = cur.pm; tab_sel ^= 1;
            rs_table_fill((LAS float*)(lds + 131072 + tab_sel * 1024), E.rs_direct, E.ssq, cur.pm, tid); } }
        const bool has_next = S.next(ui + 1, nxt);
        const char* nA = has_next ? a_ptr(g, nxt) : cA; const char* nB = has_next ? b_ptr(g, nxt) : cB;
        asm volatile(".p2align 8\n\ts_nop 0\n\ts_nop 0\n\ts_nop 0\n\ts_nop 0\n\ts_nop 0\n\ts_nop 0\n\ts_nop 0\n\ts_nop 0\n\ts_nop 0\n\ts_nop 0" ::: "memory");
        for (int t = 0; t < nt; t += 2) {
            const bool last = (t == nt - 2);
            const char* a1 = cA + (size_t)(t + 1) * kstep;
            const char* a2 = last ? nA : cA + (size_t)(t + 2) * kstep; const char* b2 = last ? nB : cB + (size_t)(t + 2) * kstep;
            const char* a3 = a2 + kstep; const char* b3 = b2 + kstep;
            PG8_LDB(B0, 0, 0); PG8_LDB(B1, 0, 1); PG8_SCHED; PG8_LDA(At, 0, 0); PG8_STAGE(PG8_SA(1, 1), a1 + hstepA, voffA);
            PG8_WAIT_V(8); PG8_WAIT_L(0); PG8_BAR; PG8_MMA(0, 0, At, B0); PG8_MMA(0, 1, At, B1); PG8_BAR; PG8_SCHED;
            PG8_LDA(At, 0, 1); PG8_STAGE(PG8_SB(0, 0), b2, voffB); PG8_STAGE(PG8_SB(0, 1), b2 + hstepB, voffB); PG8_STAGE(PG8_SA(0, 0), a2, voffA);
            PG8_WAIT_V(8); PG8_WAIT_L(0); PG8_BAR; PG8_MMA(1, 0, At, B0); PG8_MMA(1, 1, At, B1); PG8_BAR; PG8_SCHED;
            PG8_LDB(B0, 1, 0); PG8_LDB(B1, 1, 1); PG8_SCHED; PG8_LDA(At, 1, 0); PG8_STAGE(PG8_SA(0, 1), a2 + hstepA, voffA);
            PG8_WAIT_V(8); PG8_WAIT_L(0); PG8_BAR; PG8_MMA(0, 0, At, B0); PG8_MMA(0, 1, At, B1); PG8_BAR; PG8_SCHED;
            PG8_LDA(At, 1, 1); PG8_STAGE(PG8_SB(1, 0), b3, voffB); PG8_STAGE(PG8_SB(1, 1), b3 + hstepB, voffB); PG8_STAGE(PG8_SA(1, 0), a3, voffA);
            PG8_WAIT_V(8); PG8_WAIT_L(0); PG8_BAR; PG8_MMA(1, 0, At, B0); PG8_MMA(1, 1, At, B1); PG8_BAR; PG8_SCHED;
        }
        if (wr == 0) PG8_BAR;
        if constexpr (Epi::USES_RS) E.run_rs(acc, cur, wr, wc, fr, fq, (const LAS float*)(lds + 131072 + tab_sel * 1024)); else E(acc, cur, wr, wc, fr, fq);
        if (!has_next) break;
        if (!E.keep(cur)) {
#pragma unroll
            for (int a = 0; a < 2; ++a)
#pragma unroll
                for (int b = 0; b < 2; ++b)
#pragma unroll
                    for (int m = 0; m < 4; ++m)
#pragma unroll
                        for (int n = 0; n < 2; ++n) acc[a][b][m][n] = (f32x4){0.f, 0.f, 0.f, 0.f};
        }
        cur = nxt; cA = nA; cB = nB; ++ui;
        if (wr == 1) PG8_BAR;
    }
    PG8_WAIT_V(0);
    PG8_BAR;
#undef PG8_SA
#undef PG8_SB
#undef PG8_STAGE
#undef PG8_LDA
#undef PG8_LDB
#undef PG8_MMA
#undef PG8_WAIT_V
#undef PG8_WAIT_L
#undef PG8_BAR
#undef PG8_SCHED
}
}


#define XB_TMO      128
#define XB_XCNT(j)  (256  + 64 * (j))
#define XB_XSUB(j)  (1280 + 64 * (j))
#define XB_XGEN(j)  (2304 + 64 * (j))
#define XB_TOP      3328
#define XB_TOPGEN   3392
#define XCD_BAR_WORDS 3456
#define XB_SPIN_CAP (1u << 18)
__device__ __forceinline__ unsigned xb_ld(unsigned* p)              { return __hip_atomic_load(p, __ATOMIC_RELAXED, __HIP_MEMORY_SCOPE_AGENT); }
__device__ __forceinline__ unsigned xb_add(unsigned* p, unsigned v) { return __hip_atomic_fetch_add(p, v, __ATOMIC_RELAXED, __HIP_MEMORY_SCOPE_AGENT); }
__device__ __forceinline__ unsigned xb_xcc_id() { return (unsigned)__builtin_amdgcn_s_getreg((3 << 11) | 20) & 0xFu; }
#define XB_SPIN(cond, bar) do { unsigned _sp = 0; while (cond) { __builtin_amdgcn_s_sleep(1); \
    if ((++_sp & 255u) == 0u) { if (xb_ld(&(bar)[XB_TMO])) break; if (_sp > XB_SPIN_CAP) { atomicAdd(&(bar)[XB_TMO], 1u); break; } } } } while (0)
struct XcdBarrier { unsigned* bar; unsigned x; volatile LAS unsigned* st; };
__device__ __forceinline__ XcdBarrier xcd_barrier_post(unsigned* bar, volatile LAS unsigned* st) {
    XcdBarrier b; b.bar = bar; b.x = xb_xcc_id(); b.st = st;
    if (threadIdx.x == 0) (void)xb_add(&bar[XB_XCNT(b.x)], 1u);
    return b;
}
__device__ __forceinline__ void xcd_barrier_complete(unsigned* bar, unsigned x, unsigned& nloc, unsigned& nx) {
    const unsigned G = gridDim.x * gridDim.y * gridDim.z;
    unsigned sum, cnt, mine, sp = 0u;
    for (;;) {
        sum = 0u; cnt = 0u; mine = 0u;
#pragma unroll
        for (unsigned j = 0; j < 16; ++j) { const unsigned c = xb_ld(&bar[XB_XCNT(j)]); sum += c; cnt += (c > 0u) ? 1u : 0u; mine = (j == x) ? c : mine; }
        if (sum == G) break;
        __builtin_amdgcn_s_sleep(1);
        if ((++sp & 255u) == 0u) { if (xb_ld(&bar[XB_TMO])) break; if (sp > XB_SPIN_CAP) { atomicAdd(&bar[XB_TMO], 1u); break; } }
    }
    nloc = mine > 0u ? mine : 1u; nx = cnt > 0u ? cnt : 1u;
}
__device__ __forceinline__ void xcd_barrier(const XcdBarrier& b) {
    asm volatile("s_waitcnt vmcnt(0)" ::: "memory");
    __syncthreads();
    if (threadIdx.x == 0) {
        unsigned* bar = b.bar;
        __builtin_amdgcn_s_waitcnt(0);
        unsigned nloc = b.st[0], nx = b.st[1];
        if (nloc == 0u) { xcd_barrier_complete(bar, b.x, nloc, nx); b.st[0] = nloc; b.st[1] = nx; }
        const unsigned old = xb_add(&bar[XB_XSUB(b.x)], 1u);
        const unsigned gen = old / nloc;
        if (old + 1u == (gen + 1u) * nloc) {
            __builtin_amdgcn_fence(__ATOMIC_RELEASE, "agent");
            asm volatile("s_waitcnt vmcnt(0)" ::: "memory");
            const unsigned og = xb_add(&bar[XB_TOP], 1u);
            const unsigned tg = og / nx;
            if (og + 1u == (tg + 1u) * nx) xb_add(&bar[XB_TOPGEN], 1u);
            else XB_SPIN(xb_ld(&bar[XB_TOPGEN]) == tg, bar);
            __builtin_amdgcn_fence(__ATOMIC_ACQUIRE, "agent");
            xb_add(&bar[XB_XGEN(b.x)], 1u);
            asm volatile("s_waitcnt vmcnt(0)" ::: "memory");
        } else {
            XB_SPIN(xb_ld(&bar[XB_XGEN(b.x)]) == gen, bar);
            __builtin_amdgcn_fence(__ATOMIC_ACQUIRE, "agent");
            asm volatile("s_waitcnt vmcnt(0)" ::: "memory");
        }
    }
    __syncthreads();
}

struct Params {
    const float* in[21];
    float* out;
    unsigned char* ws;
    int ph_lo, ph_hi;
};
enum { I_X = 0, I_F1N, I_F1WI, I_F1WO, I_MIXN, I_WIN, I_BGATE, I_ALNG, I_ALNB, I_AWS, I_ABS, I_BWA, I_BBA, I_BHN, I_WPA, I_WPB, I_WO, I_F2N, I_F2WI, I_F2WO, I_FINN };

__device__ __forceinline__ void transpose_item(const float* W, int ldw, int src_col0, const float* gain, bf16_t* WT, int K, int dst_row0, int k0, LAS float* scr, int lane) {
    const int c4 = lane & 7, rr = lane >> 3;
    f32x4 v[8]; float gv[8];
#pragma unroll
    for (int i = 0; i < 8; ++i) { const int kk = rr + 8 * i; v[i] = *(const f32x4*)(W + (size_t)(k0 + kk) * ldw + src_col0 + 4 * c4); gv[i] = gain ? gain[k0 + kk] : 1.0f; }
#pragma unroll
    for (int i = 0; i < 8; ++i) { const int kk = rr + 8 * i; LAS float* d = scr + kk * 33 + 4 * c4; d[0] = v[i][0] * gv[i]; d[1] = v[i][1] * gv[i]; d[2] = v[i][2] * gv[i]; d[3] = v[i][3] * gv[i]; }
    asm volatile("s_waitcnt lgkmcnt(0)" ::: "memory");
    const int c = lane & 7;
#pragma unroll
    for (int j = 0; j < 4; ++j) { const int n = (lane >> 3) + 8 * j; const LAS float* s = scr + (8 * c) * 33 + n;
        u32x4 o; o.x = pk2(s[0 * 33], s[1 * 33]); o.y = pk2(s[2 * 33], s[3 * 33]); o.z = pk2(s[4 * 33], s[5 * 33]); o.w = pk2(s[6 * 33], s[7 * 33]);
        *(u32x4*)(WT + (size_t)(dst_row0 + n) * K + k0 + 8 * c) = o; }
    asm volatile("s_waitcnt lgkmcnt(0)" ::: "memory");
}
__device__ __forceinline__ void transpose_matrix_item(int it, int kind, const float* W, int ldw, int K, int ndst, const float* gain, bf16_t* WT, LAS float* scr, int lane) {
    const int nblk = ndst / 32, kb = it / nblk, nb = it % nblk, n0 = 32 * nb; int src;
    if (kind == 1) { const int pn = nb >> 3, w = nb & 7; src = (w >> 2) * DFF + 128 * pn + 32 * (w & 3); }
    else if (kind == 2) src = n0 < 5120 ? n0 : n0 + 16;
    else src = n0;
    transpose_item(W, ldw, src, gain, WT, K, n0, 64 * kb, scr, lane);
}
__device__ __forceinline__ void p0_prep(const Params& p, LAS unsigned char* lds) {
    const int tid = threadIdx.x, lane = tid & 63, wave = tid >> 6;
    const int gw = blockIdx.x * 8 + wave, NGW = gridDim.x * 8;
    LAS float* scr = (LAS float*)(lds + wave * 16384);
    unsigned char* ws = p.ws;
    constexpr int I_FI = (D / 64) * (2 * DFF / 32), I_FO = (DFF / 64) * (D / 32), I_WI = (D / 64) * (7168 / 32), I_SQ = (D / 64) * (D / 32);
    constexpr int NITEMS = 2 * I_FI + 2 * I_FO + I_WI + 3 * I_SQ;
    for (int it = gw; it < NITEMS; it += NGW) {
        int r = it;
        if (r < I_FI) { transpose_matrix_item(r, 1, p.in[I_F1WI], 2 * DFF, D, 2 * DFF, p.in[I_F1N], (bf16_t*)(ws + WS_W1IN), scr, lane); continue; } r -= I_FI;
        if (r < I_FI) { transpose_matrix_item(r, 1, p.in[I_F2WI], 2 * DFF, D, 2 * DFF, p.in[I_F2N], (bf16_t*)(ws + WS_W2IN), scr, lane); continue; } r -= I_FI;
        if (r < I_FO) { transpose_matrix_item(r, 0, p.in[I_F1WO], D, DFF, D, nullptr, (bf16_t*)(ws + WS_W1OUT), scr, lane); continue; } r -= I_FO;
        if (r < I_FO) { transpose_matrix_item(r, 0, p.in[I_F2WO], D, DFF, D, nullptr, (bf16_t*)(ws + WS_W2OUT), scr, lane); continue; } r -= I_FO;
        if (r < I_WI) { transpose_matrix_item(r, 2, p.in[I_WIN], 7184, D, 7168, p.in[I_MIXN], (bf16_t*)(ws + WS_WIN), scr, lane); continue; } r -= I_WI;
        if (r < I_SQ) { transpose_matrix_item(r, 0, p.in[I_WPA], D, D, D, nullptr, (bf16_t*)(ws + WS_WPA), scr, lane); continue; } r -= I_SQ;
        if (r < I_SQ) { transpose_matrix_item(r, 0, p.in[I_WPB], D, D, D, p.in[I_BHN], (bf16_t*)(ws + WS_WPB), scr, lane); continue; } r -= I_SQ;
        transpose_matrix_item(r, 0, p.in[I_WO], D, D, D, nullptr, (bf16_t*)(ws + WS_WO), scr, lane);
    }
    {
        bf16_t* WT = (bf16_t*)(ws + WS_WIN) + (size_t)7168 * D; const float* W = p.in[I_WIN]; const float* wa = p.in[I_BWA]; const float* gn = p.in[I_MIXN];
        for (int idx = blockIdx.x * NTHREADS + tid; idx < 512 * D; idx += gridDim.x * NTHREADS) { const int n = idx >> 10, k = idx & 1023; float s = 0.f;
#pragma unroll
            for (int r = 0; r < 16; ++r) s += W[(size_t)k * 7184 + 5120 + r] * wa[r * 512 + n];
            WT[idx] = (bf16_t)f2bf(s * gn[k]); }
    }
    {
        const float* x = p.in[I_X]; bf16_t* xb = (bf16_t*)(ws + WS_XB); float* rs0 = (float*)(ws + WS_RS0);
        for (int m0 = gw * 4; m0 < T; m0 += NGW * 4) { f32x4 v[4][4];
#pragma unroll
            for (int q = 0; q < 4; ++q)
#pragma unroll
                for (int j = 0; j < 4; ++j) v[q][j] = *((const f32x4*)(x + (size_t)(m0 + q) * D) + lane + 64 * j);
#pragma unroll
            for (int q = 0; q < 4; ++q) { unsigned long long* o8 = (unsigned long long*)(xb + (size_t)(m0 + q) * D) + lane; float s = 0.f;
#pragma unroll
                for (int j = 0; j < 4; ++j) { const f32x4 t = v[q][j]; s += (t[0] * t[0] + t[1] * t[1]) + (t[2] * t[2] + t[3] * t[3]); o8[64 * j] = (unsigned long long)cvt2(t[0], t[1]) | ((unsigned long long)cvt2(t[2], t[3]) << 32); }
                s = wave_sum(s); if (lane == 0) rs0[m0 + q] = __builtin_amdgcn_rsqf(s * (1.0f / D) + EPS); } }
    }
}

#define LDS_BARRIER() do { asm volatile("s_waitcnt lgkmcnt(0)" ::: "memory"); __builtin_amdgcn_s_barrier(); asm volatile("" ::: "memory"); } while (0)

namespace gla2 {
constexpr int QP = 272, QOP = 264, JP = 144;
constexpr int OFF_QI = 0, OFF_KI = OFF_QI + 64 * QP, OFF_QO = OFF_KI + 64 * QP, OFF_KST = OFF_QO + 64 * QOP, OFF_VT = OFF_KST + 128 * JP, OFF_PL = OFF_VT + 256 * JP,
              OFF_TOT = OFF_PL + 64 * JP, OFF_DEC = OFF_TOT + 4096, OFF_RED = OFF_DEC + 512, OFF_HG = OFF_RED + 2048, END = OFF_HG + 1024;
static_assert(END <= 131072 && OFF_QO % 16 == 0 && OFF_KST % 16 == 0 && OFF_VT % 16 == 0 && OFF_PL % 16 == 0 && OFF_TOT % 16 == 0 && OFF_HG % 16 == 0, "gla2 lds map");
constexpr int NSEG = 8, LSEG = (SEQ / 64) / NSEG, NITEMS = 32 * NSEG;
}
template <bool FULL>
__device__ __forceinline__ void gla_run(const Params& p, LAS unsigned char* lds, int b, int h, int n_begin, int n_end, f32x16 (&X)[4], float& dprod) {
    using namespace gla2;
    const int tid = threadIdx.x, lane = tid & 63, wave = __builtin_amdgcn_readfirstlane(tid >> 6), r = lane & 31, hh = lane >> 5;
    unsigned char* ws = p.ws;
    const bf16_t* Q = (const bf16_t*)(ws + WS_Q); const bf16_t* Kb = (const bf16_t*)(ws + WS_K); const bf16_t* VB = (const bf16_t*)(ws + WS_VB); const bf16_t* LA = (const bf16_t*)(ws + WS_LA);
    bf16_t* R = (bf16_t*)(ws + WS_R);
    constexpr bool full = FULL;
    const int kp = lane, jg = wave;
    const int vp = tid & 127, jq = tid >> 7;
    LDS_BARRIER();
    if (wave >= 4) __builtin_amdgcn_s_setprio(1);
    unsigned qw[8], kw[8], lw[8], vw[16];
    const size_t rowb = (size_t)b * SEQ;
#define GLA_LOAD_QKL(n) do { \
        _Pragma("unroll") for (int jj = 0; jj < 8; ++jj) { const size_t row = rowb + 64 * (n) + 8 * jg + jj; \
            qw[jj] = *(const unsigned*)(Q + row * 512 + h * 128 + 2 * kp); kw[jj] = *(const unsigned*)(Kb + row * 512 + h * 128 + 2 * kp); lw[jj] = *(const unsigned*)(LA + row * 512 + h * 128 + 2 * kp); } } while (0)
#define GLA_LOAD_V(n) do { \
        _Pragma("unroll") for (int jj = 0; jj < 16; ++jj) { const size_t row = rowb + 64 * (n) + 16 * jq + jj; vw[jj] = *(const unsigned*)(VB + row * 1024 + h * 256 + 2 * vp); } } while (0)
    GLA_LOAD_QKL(n_begin); GLA_LOAD_V(n_begin);
    for (int n = n_begin; n < n_end; ++n) {
        f32x2 pre = {0.f, 0.f}, mid = {0.f, 0.f}, last = {0.f, 0.f};
        {
            float run0 = 0.f, run1 = 0.f;
#pragma unroll
            for (int jj = 0; jj < 8; ++jj) { run0 += bflo(lw[jj]); run1 += bfhi(lw[jj]); }
            *(LAS f32x2*)(lds + OFF_TOT + (jg * 128 + 2 * kp) * 4) = (f32x2){run0, run1};
            u32x4 lo0, lo1, hi0, hi1;
#pragma unroll
            for (int m = 0; m < 4; ++m) { lo0[m] = (vw[2 * m] & 0xffffu) | (vw[2 * m + 1] << 16); hi0[m] = (vw[2 * m] >> 16) | (vw[2 * m + 1] & 0xffff0000u);
                                          lo1[m] = (vw[8 + 2 * m] & 0xffffu) | (vw[8 + 2 * m + 1] << 16); hi1[m] = (vw[8 + 2 * m] >> 16) | (vw[8 + 2 * m + 1] & 0xffff0000u); }
            LAS unsigned char* v0 = lds + OFF_VT + (2 * vp) * JP + 2 * (16 * jq); LAS unsigned char* v1 = v0 + JP;
            *(LAS u32x4*)v0 = lo0; *(LAS u32x4*)(v0 + 16) = lo1; *(LAS u32x4*)v1 = hi0; *(LAS u32x4*)(v1 + 16) = hi1;
        }
        LDS_BARRIER();
        {
#pragma unroll
            for (int g = 0; g < 8; ++g) { const f32x2 t = *(const LAS f32x2*)(lds + OFF_TOT + (g * 128 + 2 * kp) * 4); if (g < jg) pre += t; if (g < 4) mid += t; last += t; }
            const float EM0 = __builtin_amdgcn_exp2f(mid.x), EM1 = __builtin_amdgcn_exp2f(mid.y), EL0 = __builtin_amdgcn_exp2f(last.x - mid.x), EL1 = __builtin_amdgcn_exp2f(last.y - mid.y);
            if (jg == 0) *(LAS f32x2*)(lds + OFF_DEC + 2 * kp * 4) = (f32x2){__builtin_amdgcn_exp2f(last.x), __builtin_amdgcn_exp2f(last.y)};
            f32x8 ks0, ks1; float run0 = pre.x - mid.x, run1 = pre.y - mid.y;
#pragma unroll
            for (int jj = 0; jj < 8; ++jj) {
                run0 += bflo(lw[jj]); run1 += bfhi(lw[jj]);
                const float e0 = __builtin_amdgcn_exp2f(run0), e1 = __builtin_amdgcn_exp2f(run1), r0 = __builtin_amdgcn_rcpf(e0), r1 = __builtin_amdgcn_rcpf(e1);
                const float ki0 = bflo(kw[jj]) * r0, ki1 = bfhi(kw[jj]) * r1;
                ks0[jj] = ki0 * EL0; ks1[jj] = ki1 * EL1;
                if (full) { const float qi0 = bflo(qw[jj]) * e0, qi1 = bfhi(qw[jj]) * e1; const int row = 8 * jg + jj;
                    *(LAS unsigned*)(lds + OFF_QI + row * QP + 4 * kp) = cvt2(qi0, qi1);
                    *(LAS unsigned*)(lds + OFF_KI + row * QP + 4 * kp) = cvt2(ki0, ki1);
                    *(LAS unsigned*)(lds + OFF_QO + row * QOP + 4 * kp) = cvt2(qi0 * EM0, qi1 * EM1); }
            }
            *(LAS bf16x8*)(lds + OFF_KST + (2 * kp) * JP + 16 * jg) = cvt8(ks0);
            *(LAS bf16x8*)(lds + OFF_KST + (2 * kp + 1) * JP + 16 * jg) = cvt8(ks1);
        }
        const int nn = (n + 1 < n_end) ? n + 1 : n;
        GLA_LOAD_QKL(nn);
        bf16_t* const rp0 = R + (rowb + 64 * n + r) * 1024 + h * 256 + 32 * wave + 4 * hh;
        LDS_BARRIER();
        if (full) {
#pragma unroll
            for (int tt = 0; tt < 2; ++tt) { const int t = 2 * wave + tt, jt = t >> 2, it = t & 3; f32x4 acc = {0.f, 0.f, 0.f, 0.f};
                if (jt <= it) {
                    bf16x8 A[4], B[4];
#pragma unroll
                    for (int ks = 0; ks < 4; ++ks) { A[ks] = *(const LAS bf16x8*)(lds + OFF_KI + (16 * jt + (lane & 15)) * QP + 2 * (32 * ks + 8 * (lane >> 4)));
                                                     B[ks] = *(const LAS bf16x8*)(lds + OFF_QI + (16 * it + (lane & 15)) * QP + 2 * (32 * ks + 8 * (lane >> 4))); }
#pragma unroll
                    for (int ks = 0; ks < 4; ++ks) acc = __builtin_amdgcn_mfma_f32_16x16x32_bf16(A[ks], B[ks], acc, 0, 0, 0);
                }
                const int i = 16 * it + (lane & 15), j0 = 16 * jt + 4 * (lane >> 4);
                u32x2 o; o.x = cvt2(j0 <= i ? acc[0] : 0.f, j0 + 1 <= i ? acc[1] : 0.f); o.y = cvt2(j0 + 2 <= i ? acc[2] : 0.f, j0 + 3 <= i ? acc[3] : 0.f);
                *(LAS u32x2*)(lds + OFF_PL + i * JP + 2 * j0) = o; }
            LDS_BARRIER();
        }
        if (!FULL && tid < 128) dprod *= *(const LAS float*)(lds + OFF_DEC + tid * 4);
        const LAS unsigned char* vrow = lds + OFF_VT + (32 * wave + r) * JP + 16 * hh;
        bf16x8 vf[4];
#pragma unroll
        for (int ks = 0; ks < 4; ++ks) vf[ks] = *(const LAS bf16x8*)(vrow + 32 * ks);
        f32x16 oT[2];
        if (full) {
#pragma unroll
            for (int it2 = 0; it2 < 2; ++it2)
#pragma unroll
                for (int e = 0; e < 16; ++e) oT[it2][e] = 0.f;
            {
                bf16x8 p0[2], p1[4];
#pragma unroll
                for (int ks = 0; ks < 2; ++ks) p0[ks] = *(const LAS bf16x8*)(lds + OFF_PL + r * JP + 32 * ks + 16 * hh);
#pragma unroll
                for (int ks = 0; ks < 4; ++ks) p1[ks] = *(const LAS bf16x8*)(lds + OFF_PL + (32 + r) * JP + 32 * ks + 16 * hh);
                oT[0] = __builtin_amdgcn_mfma_f32_32x32x16_bf16(vf[0], p0[0], oT[0], 0, 0, 0); oT[1] = __builtin_amdgcn_mfma_f32_32x32x16_bf16(vf[0], p1[0], oT[1], 0, 0, 0);
                oT[0] = __builtin_amdgcn_mfma_f32_32x32x16_bf16(vf[1], p0[1], oT[0], 0, 0, 0); oT[1] = __builtin_amdgcn_mfma_f32_32x32x16_bf16(vf[1], p1[1], oT[1], 0, 0, 0);
                oT[1] = __builtin_amdgcn_mfma_f32_32x32x16_bf16(vf[2], p1[2], oT[1], 0, 0, 0); oT[1] = __builtin_amdgcn_mfma_f32_32x32x16_bf16(vf[3], p1[3], oT[1], 0, 0, 0);
            }
            __builtin_amdgcn_sched_barrier(0);
#pragma unroll
            for (int kh = 0; kh < 2; ++kh) {
                u32x4 bq[2][2][2];
#pragma unroll
                for (int k2 = 0; k2 < 2; ++k2)
#pragma unroll
                    for (int s = 0; s < 2; ++s)
#pragma unroll
                        for (int it2 = 0; it2 < 2; ++it2) { const LAS unsigned char* qp = lds + OFF_QO + (32 * it2 + r) * QOP + 2 * (32 * (2 * kh + k2) + 16 * s + 4 * hh);
                            const u32x2 b0 = *(const LAS u32x2*)qp, b1 = *(const LAS u32x2*)(qp + 16); bq[k2][s][it2] = (u32x4){b0.x, b0.y, b1.x, b1.y}; }
#pragma unroll
                for (int k2 = 0; k2 < 2; ++k2)
#pragma unroll
                    for (int s = 0; s < 2; ++s) { f32x8 xs;
#pragma unroll
                        for (int e = 0; e < 8; ++e) xs[e] = X[2 * kh + k2][8 * s + e];
                        const bf16x8 A = cvt8(xs);
                        oT[0] = __builtin_amdgcn_mfma_f32_32x32x16_bf16(A, __builtin_bit_cast(bf16x8, bq[k2][s][0]), oT[0], 0, 0, 0);
                        oT[1] = __builtin_amdgcn_mfma_f32_32x32x16_bf16(A, __builtin_bit_cast(bf16x8, bq[k2][s][1]), oT[1], 0, 0, 0); }
                __builtin_amdgcn_sched_barrier(0);
            }
        }
        __builtin_amdgcn_sched_barrier(0);
        GLA_LOAD_V(nn);
        __builtin_amdgcn_sched_barrier(0);
#pragma unroll
        for (int kh = 0; kh < 2; ++kh) {
            bf16x8 ka[2][4];
#pragma unroll
            for (int k2 = 0; k2 < 2; ++k2)
#pragma unroll
                for (int ks = 0; ks < 4; ++ks) ka[k2][ks] = *(const LAS bf16x8*)(lds + OFF_KST + (32 * (2 * kh + k2) + r) * JP + 32 * ks + 16 * hh);
#pragma unroll
            for (int k2 = 0; k2 < 2; ++k2)
#pragma unroll
                for (int g4 = 0; g4 < 4; ++g4) { const f32x4 dv = *(const LAS f32x4*)(lds + OFF_DEC + (32 * (2 * kh + k2) + 8 * g4 + 4 * hh) * 4);
#pragma unroll
                    for (int e = 0; e < 4; ++e) X[2 * kh + k2][4 * g4 + e] *= dv[e]; }
#pragma unroll
            for (int ks = 0; ks < 4; ++ks)
#pragma unroll
                for (int k2 = 0; k2 < 2; ++k2) X[2 * kh + k2] = __builtin_amdgcn_mfma_f32_32x32x16_bf16(ka[k2][ks], vf[ks], X[2 * kh + k2], 0, 0, 0);
            __builtin_amdgcn_sched_barrier(0);
        }
        if (full) {
            bf16_t* const rq0 = R + (rowb + 64 * n + (lane >> 2)) * 1024 + h * 256 + 32 * wave + 8 * (lane & 3);
            u32x4 rq[4];
#pragma unroll
            for (int k = 0; k < 4; ++k) rq[k] = *(const u32x4*)(rq0 + (size_t)k * 16 * 1024);
#pragma unroll
            for (int it2 = 0; it2 < 2; ++it2) { float ss = 0.f;
#pragma unroll
                for (int e = 0; e < 16; ++e) ss += oT[it2][e] * oT[it2][e];
                ss += __shfl_xor(ss, 32);
                if (hh == 0) *(LAS float*)(lds + OFF_RED + ((32 * it2 + r) * 8 + wave) * 4) = ss; }
            LDS_BARRIER();
            LAS unsigned char* stg = lds + OFF_VT + (32 * wave) * JP;
#pragma unroll
            for (int it2 = 0; it2 < 2; ++it2) { const f32x4 s0 = *(const LAS f32x4*)(lds + OFF_RED + (32 * it2 + r) * 32), s1 = *(const LAS f32x4*)(lds + OFF_RED + (32 * it2 + r) * 32 + 16);
                const float rs = __builtin_amdgcn_rsqf(((s0[0] + s0[1]) + (s0[2] + s0[3]) + (s1[0] + s1[1]) + (s1[2] + s1[3])) * (1.0f / 256.0f) + EPS);
#pragma unroll
                for (int g4 = 0; g4 < 4; ++g4) { u32x2 o; o.x = cvt2(oT[it2][4 * g4 + 0] * rs, oT[it2][4 * g4 + 1] * rs); o.y = cvt2(oT[it2][4 * g4 + 2] * rs, oT[it2][4 * g4 + 3] * rs);
                    *(LAS u32x2*)(stg + (32 * it2 + r) * 72 + 2 * (8 * g4 + 4 * hh)) = o; } }
            asm volatile("s_waitcnt lgkmcnt(0)" ::: "memory");
#pragma unroll
            for (int k = 0; k < 4; ++k) { const LAS unsigned char* sp = stg + ((lane >> 2) + 16 * k) * 72 + 16 * (lane & 3);
                const u32x2 a = *(const LAS u32x2*)sp, b = *(const LAS u32x2*)(sp + 8); const u32x4 rv = rq[k]; u32x4 o;
                o.x = cvt2(bflo(a.x) * bflo(rv.x), bfhi(a.x) * bfhi(rv.x)); o.y = cvt2(bflo(a.y) * bflo(rv.y), bfhi(a.y) * bfhi(rv.y));
                o.z = cvt2(bflo(b.x) * bflo(rv.z), bfhi(b.x) * bfhi(rv.z)); o.w = cvt2(bflo(b.y) * bflo(rv.w), bfhi(b.y) * bfhi(rv.w));
                *(u32x4*)(rq0 + (size_t)k * 16 * 1024) = o; }
        }
        LDS_BARRIER();
    }
    __builtin_amdgcn_s_setprio(0);
#undef GLA_LOAD_QKL
#undef GLA_LOAD_V
}

namespace gm2 {
constexpr int WP = 272;
constexpr int OFF_WS = 0, OFF_VT = 128 * WP, OFF_MU = 2 * 128 * WP, OFF_RS = OFF_MU + 512, OFF_NXT = OFF_RS + 512;
}
__device__ __forceinline__ void p4_gmlp2(const Params& p, LAS unsigned char* lds, unsigned* ctr) {
    using namespace gm2;
    const int tid = threadIdx.x, lane = tid & 63, wave = __builtin_amdgcn_readfirstlane(tid >> 6), r = lane & 31, hh = lane >> 5;
    unsigned char* ws = p.ws;
    bf16_t* U = (bf16_t*)(ws + WS_U); const bf16_t* V = (const bf16_t*)(ws + WS_V); const float* lnst = (const float*)(ws + WS_LNST);
    const float* lg = p.in[I_ALNG]; const float* lb = p.in[I_ALNB]; const float* Wsg = p.in[I_AWS]; const float* bs = p.in[I_ABS];
    LAS float* mu = (LAS float*)(lds + OFF_MU); LAS float* rstd = (LAS float*)(lds + OFF_RS); LAS int* nxt = (LAS int*)(lds + OFF_NXT);
    const int it = wave >> 1, ct0 = 2 * (wave & 1), cp = lane, jg = wave, tok = tid >> 2, sub = tid & 3;
    for (int gi = 0; gi < 8; ++gi) {
        const int g = (blockIdx.x + gi) & 7;
        LDS_BARRIER();
        if (tid == 0) { const int c0 = (int)atomicAdd(ctr + g, 1u); const int c1 = (int)atomicAdd(ctr + g, 1u); nxt[0] = c0; nxt[1] = c1; }
        LDS_BARRIER();
        int chunk = nxt[0], next = nxt[1];
        if (chunk >= 512) continue;
        for (int e = tid; e < 128 * 64; e += NTHREADS) { const int i = e >> 6, j = 2 * (e & 63); const f32x2 w = *(const f32x2*)(Wsg + (size_t)g * 16384 + i * 128 + j);
            *(LAS unsigned*)(lds + OFF_WS + i * WP + 2 * j) = cvt2(j <= i ? w.x : 0.f, j + 1 <= i ? w.y : 0.f); }
        const f32x2 lgv = *(const f32x2*)(lg + g * 128 + 2 * cp), lbv = *(const f32x2*)(lb + g * 128 + 2 * cp);
        unsigned vw[16]; f32x4 st0, st1;
#define GM_LOAD_RAW(ch) do { const size_t t0_ = (size_t)(ch) * 128; \
            _Pragma("unroll") for (int jj = 0; jj < 16; ++jj) vw[jj] = *(const unsigned*)(V + (t0_ + 16 * jg + jj) * 1024 + g * 128 + 2 * cp); \
            st0 = *(const f32x4*)(lnst + (t0_ + tok) * 32 + sub * 8); st1 = *(const f32x4*)(lnst + (t0_ + tok) * 32 + sub * 8 + 4); } while (0)
        GM_LOAD_RAW(chunk);
        while (chunk < 512) {
            const size_t t0 = (size_t)chunk * 128;
            int next2 = 0; if (tid == 0) next2 = (int)atomicAdd(ctr + g, 1u);
            const int i = 32 * it + r;
            u32x2 uw[2][4];
#pragma unroll
            for (int cc = 0; cc < 2; ++cc)
#pragma unroll
                for (int g4 = 0; g4 < 4; ++g4) uw[cc][g4] = *(const u32x2*)(U + (t0 + i) * 1024 + g * 128 + 32 * (ct0 + cc) + 8 * g4 + 4 * hh);
            const float bsv = bs[g * 128 + i];
            {
                float s1 = (st0[0] + st0[2]) + (st1[0] + st1[2]), s2 = (st0[1] + st0[3]) + (st1[1] + st1[3]);
                s1 += __shfl_xor(s1, 1); s2 += __shfl_xor(s2, 1); s1 += __shfl_xor(s1, 2); s2 += __shfl_xor(s2, 2);
                const float mean = s1 * (1.0f / 1024.0f), var = s2 * (1.0f / 1024.0f) - mean * mean;
                LDS_BARRIER();
                if (sub == 0) { mu[tok] = mean; rstd[tok] = 1.0f / sqrtf(fmaxf(var, 0.f) + EPS); }
            }
            LDS_BARRIER();
            {
                f32x8 a0[2], a1[2];
#pragma unroll
                for (int jj = 0; jj < 16; ++jj) { const float m = mu[16 * jg + jj], rs = rstd[16 * jg + jj];
                    a0[jj >> 3][jj & 7] = (bflo(vw[jj]) - m) * rs * lgv.x + lbv.x; a1[jj >> 3][jj & 7] = (bfhi(vw[jj]) - m) * rs * lgv.y + lbv.y; }
#pragma unroll
                for (int q = 0; q < 2; ++q) { *(LAS bf16x8*)(lds + OFF_VT + (2 * cp) * WP + 2 * (16 * jg + 8 * q)) = cvt8(a0[q]); *(LAS bf16x8*)(lds + OFF_VT + (2 * cp + 1) * WP + 2 * (16 * jg + 8 * q)) = cvt8(a1[q]); }
            }
            { const int nn = next < 512 ? next : 511; GM_LOAD_RAW(nn); }
            LDS_BARRIER();
            f32x16 acc[2];
#pragma unroll
            for (int cc = 0; cc < 2; ++cc)
#pragma unroll
                for (int e = 0; e < 16; ++e) acc[cc][e] = 0.f;
            const int nks = 2 * it + 2;
            for (int ks = 0; ks < nks; ks += 2) {
                bf16x8 B[2], A[2][2];
#pragma unroll
                for (int k2 = 0; k2 < 2; ++k2) { B[k2] = *(const LAS bf16x8*)(lds + OFF_WS + (32 * it + r) * WP + 2 * (16 * (ks + k2) + 8 * hh));
#pragma unroll
                    for (int cc = 0; cc < 2; ++cc) A[k2][cc] = *(const LAS bf16x8*)(lds + OFF_VT + (32 * (ct0 + cc) + r) * WP + 2 * (16 * (ks + k2) + 8 * hh)); }
#pragma unroll
                for (int k2 = 0; k2 < 2; ++k2)
#pragma unroll
                    for (int cc = 0; cc < 2; ++cc) acc[cc] = __builtin_amdgcn_mfma_f32_32x32x16_bf16(A[k2][cc], B[k2], acc[cc], 0, 0, 0);
            }
#pragma unroll
            for (int cc = 0; cc < 2; ++cc)
#pragma unroll
                for (int g4 = 0; g4 < 4; ++g4) { const u32x2 w = uw[cc][g4]; u32x2 o;
                    o.x = cvt2(bflo(w.x) * (acc[cc][4 * g4 + 0] + bsv), bfhi(w.x) * (acc[cc][4 * g4 + 1] + bsv)); o.y = cvt2(bflo(w.y) * (acc[cc][4 * g4 + 2] + bsv), bfhi(w.y) * (acc[cc][4 * g4 + 3] + bsv));
                    *(u32x2*)(U + (t0 + i) * 1024 + g * 128 + 32 * (ct0 + cc) + 8 * g4 + 4 * hh) = o; }
            if (tid == 0) nxt[2] = next2;
            LDS_BARRIER();
            chunk = next; next = nxt[2];
        }
#undef GM_LOAD_RAW
    }
    LDS_BARRIER();
}


namespace gm3 {
constexpr int WP = 272;
constexpr int OFF_WS = 0, OFF_VT0 = 128 * WP, OFF_VT1 = 2 * 128 * WP, OFF_MU = 3 * 128 * WP, OFF_SLOT = OFF_MU + 1024, OFF_OUT = OFF_SLOT + 512;
}
__device__ __forceinline__ void p4_gmlp3(const Params& p, LAS unsigned char* lds, unsigned* ctr) {
    using namespace gm3;
    const int tid = threadIdx.x, lane = tid & 63, wave = __builtin_amdgcn_readfirstlane(tid >> 6), r = lane & 31, hh = lane >> 5;
    unsigned char* ws = p.ws;
    bf16_t* U = (bf16_t*)(ws + WS_U); const bf16_t* V = (const bf16_t*)(ws + WS_V); const float* lnst = (const float*)(ws + WS_LNST);
    const float* lg = p.in[I_ALNG]; const float* lb = p.in[I_ALNB]; const float* Wsg = p.in[I_AWS]; const float* bs = p.in[I_ABS];
    LAS float* muw = (LAS float*)(lds + OFF_MU) + wave * 32;
    LAS int* slot = (LAS int*)(lds + OFF_SLOT);
    const int ct = wave & 3, ita = (wave < 4) ? 0 : 1, itb = 3 - ita;
    const int cp = lane, jg = wave, tsub = lane >> 2, sub = lane & 3;
    if (wave >= 4) __builtin_amdgcn_s_setprio(1);
    for (int gi = 0; gi < 8; ++gi) {
        const int g = (blockIdx.x + gi) & 7;
        LDS_BARRIER();
        if (tid == 0) { slot[0] = (int)atomicAdd(ctr + g, 1u); slot[1] = (int)atomicAdd(ctr + g, 1u); slot[2] = (int)atomicAdd(ctr + g, 1u); }
        LDS_BARRIER();
        int cur = slot[0], nxc = slot[1], nn2 = slot[2];
        if (cur >= 512) continue;
        for (int e = tid; e < 128 * 64; e += NTHREADS) { const int i = e >> 6, j = 2 * (e & 63); const f32x2 w = *(const f32x2*)(Wsg + (size_t)g * 16384 + i * 128 + j);
            *(LAS unsigned*)(lds + OFF_WS + i * WP + 2 * j) = cvt2(j <= i ? w.x : 0.f, j + 1 <= i ? w.y : 0.f); }
        const f32x2 lgv = *(const f32x2*)(lg + g * 128 + 2 * cp), lbv = *(const f32x2*)(lb + g * 128 + 2 * cp);
        const float bsa = bs[g * 128 + 32 * ita + r], bsb = bs[g * 128 + 32 * itb + r];
        unsigned vw[16]; f32x4 st0, st1;
#define GM_LOAD_RAW(ch) do { const size_t t0_ = (size_t)(ch) * 128; \
            _Pragma("unroll") for (int jj = 0; jj < 16; ++jj) vw[jj] = *(const unsigned*)(V + (t0_ + 16 * jg + jj) * 1024 + g * 128 + 2 * cp); \
            st0 = *(const f32x4*)(lnst + (t0_ + 16 * jg + tsub) * 32 + sub * 8); st1 = *(const f32x4*)(lnst + (t0_ + 16 * jg + tsub) * 32 + sub * 8 + 4); } while (0)
#define GM_LN(vt) do { \
            float s1_ = (st0[0] + st0[2]) + (st1[0] + st1[2]), s2_ = (st0[1] + st0[3]) + (st1[1] + st1[3]); \
            s1_ += __shfl_xor(s1_, 1); s2_ += __shfl_xor(s2_, 1); s1_ += __shfl_xor(s1_, 2); s2_ += __shfl_xor(s2_, 2); \
            const float mean_ = s1_ * (1.0f / 1024.0f), var_ = s2_ * (1.0f / 1024.0f) - mean_ * mean_; \
            if (sub == 0) *(LAS f32x2*)(muw + 2 * tsub) = (f32x2){mean_, __builtin_amdgcn_rsqf(fmaxf(var_, 0.f) + EPS)}; \
            asm volatile("s_waitcnt lgkmcnt(0)" ::: "memory"); \
            f32x8 a0_[2], a1_[2]; \
            _Pragma("unroll") for (int q_ = 0; q_ < 8; ++q_) { const f32x4 mr_ = *(const LAS f32x4*)(muw + 4 * q_); \
                a0_[q_ >> 2][(2 * q_) & 7] = (bflo(vw[2 * q_]) - mr_[0]) * mr_[1] * lgv.x + lbv.x; a1_[q_ >> 2][(2 * q_) & 7] = (bfhi(vw[2 * q_]) - mr_[0]) * mr_[1] * lgv.y + lbv.y; \
                a0_[q_ >> 2][(2 * q_ + 1) & 7] = (bflo(vw[2 * q_ + 1]) - mr_[2]) * mr_[3] * lgv.x + lbv.x; a1_[q_ >> 2][(2 * q_ + 1) & 7] = (bfhi(vw[2 * q_ + 1]) - mr_[2]) * mr_[3] * lgv.y + lbv.y; } \
            _Pragma("unroll") for (int q_ = 0; q_ < 2; ++q_) { *(LAS bf16x8*)((vt) + (2 * cp) * WP + 2 * (16 * jg + 8 * q_)) = cvt8(a0_[q_]); *(LAS bf16x8*)((vt) + (2 * cp + 1) * WP + 2 * (16 * jg + 8 * q_)) = cvt8(a1_[q_]); } \
            asm volatile("s_waitcnt lgkmcnt(0)" ::: "memory"); } while (0)
        GM_LOAD_RAW(cur);
        GM_LN(lds + OFF_VT0);
        { const int c1 = nxc < 512 ? nxc : 511; GM_LOAD_RAW(c1); }
        int tk = 0; if (tid == 0) tk = (int)atomicAdd(ctr + g, 1u);
        int buf = 0;
        while (cur < 512) {
            const size_t t0 = (size_t)cur * 128;
            const int nn = nn2;
            if (tid == 0) slot[buf] = tk;
            LDS_BARRIER();
            nn2 = slot[buf];
            if (tid == 0) tk = (int)atomicAdd(ctr + g, 1u);
            LAS unsigned char* vt = lds + (buf ? OFF_VT1 : OFF_VT0);
            u32x4 uq[4];
#pragma unroll
            for (int k = 0; k < 4; ++k) uq[k] = *(const u32x4*)(U + (t0 + (tid >> 4) + 32 * k) * 1024 + g * 128 + 8 * (tid & 15));
            f32x16 acca, accb;
#pragma unroll
            for (int e = 0; e < 16; ++e) { acca[e] = 0.f; accb[e] = 0.f; }
            for (int ks = 0; ks < 2 * ita + 2; ++ks) { const bf16x8 A = *(const LAS bf16x8*)(vt + (32 * ct + r) * WP + 2 * (16 * ks + 8 * hh));
                const bf16x8 Ba = *(const LAS bf16x8*)(lds + OFF_WS + (32 * ita + r) * WP + 2 * (16 * ks + 8 * hh)), Bb = *(const LAS bf16x8*)(lds + OFF_WS + (32 * itb + r) * WP + 2 * (16 * ks + 8 * hh));
                acca = __builtin_amdgcn_mfma_f32_32x32x16_bf16(A, Ba, acca, 0, 0, 0); accb = __builtin_amdgcn_mfma_f32_32x32x16_bf16(A, Bb, accb, 0, 0, 0); }
            for (int ks = 2 * ita + 2; ks < 2 * itb + 2; ++ks) { const bf16x8 A = *(const LAS bf16x8*)(vt + (32 * ct + r) * WP + 2 * (16 * ks + 8 * hh));
                const bf16x8 Bb = *(const LAS bf16x8*)(lds + OFF_WS + (32 * itb + r) * WP + 2 * (16 * ks + 8 * hh));
                accb = __builtin_amdgcn_mfma_f32_32x32x16_bf16(A, Bb, accb, 0, 0, 0); }
            if (nxc < 512) GM_LN(lds + (buf ? OFF_VT0 : OFF_VT1));
            { const int c2 = nn < 512 ? nn : 511; GM_LOAD_RAW(c2); }
#pragma unroll
            for (int g4 = 0; g4 < 4; ++g4) {
                u32x2 o; o.x = cvt2(acca[4 * g4 + 0] + bsa, acca[4 * g4 + 1] + bsa); o.y = cvt2(acca[4 * g4 + 2] + bsa, acca[4 * g4 + 3] + bsa);
                *(LAS u32x2*)(lds + OFF_OUT + (32 * ita + r) * WP + 2 * (32 * ct + 8 * g4 + 4 * hh)) = o;
                o.x = cvt2(accb[4 * g4 + 0] + bsb, accb[4 * g4 + 1] + bsb); o.y = cvt2(accb[4 * g4 + 2] + bsb, accb[4 * g4 + 3] + bsb);
                *(LAS u32x2*)(lds + OFF_OUT + (32 * itb + r) * WP + 2 * (32 * ct + 8 * g4 + 4 * hh)) = o; }
            LDS_BARRIER();
#pragma unroll
            for (int k = 0; k < 4; ++k) { const u32x4 sp = *(const LAS u32x4*)(lds + OFF_OUT + ((tid >> 4) + 32 * k) * WP + 16 * (tid & 15)); const u32x4 uu = uq[k]; u32x4 o;
                o.x = cvt2(bflo(uu.x) * bflo(sp.x), bfhi(uu.x) * bfhi(sp.x)); o.y = cvt2(bflo(uu.y) * bflo(sp.y), bfhi(uu.y) * bfhi(sp.y));
                o.z = cvt2(bflo(uu.z) * bflo(sp.z), bfhi(uu.z) * bfhi(sp.z)); o.w = cvt2(bflo(uu.w) * bflo(sp.w), bfhi(uu.w) * bfhi(sp.w));
                *(u32x4*)(U + (t0 + (tid >> 4) + 32 * k) * 1024 + g * 128 + 8 * (tid & 15)) = o; }
            cur = nxc; nxc = nn; buf ^= 1;
        }
#undef GM_LOAD_RAW
#undef GM_LN
    }
    __builtin_amdgcn_s_setprio(0);
    LDS_BARRIER();
}

__device__ __forceinline__ void p4_gla_pass1(const Params& p, LAS unsigned char* lds) {
    using namespace gla2;
    const int tid = threadIdx.x, lane = tid & 63, wave = __builtin_amdgcn_readfirstlane(tid >> 6);
    float* E = (float*)(p.ws + WS_GLAE); float* Dg = (float*)(p.ws + WS_GLAD);
    for (int item = blockIdx.x; item < NITEMS; item += gridDim.x) {
        const int bh = item / NSEG, seg = item - bh * NSEG; if (seg == NSEG - 1) continue;
        f32x16 X[4];
#pragma unroll
        for (int kt = 0; kt < 4; ++kt)
#pragma unroll
            for (int e = 0; e < 16; ++e) X[kt][e] = 0.f;
        float dprod = 1.f;
        gla_run<false>(p, lds, bh >> 2, bh & 3, seg * LSEG, (seg + 1) * LSEG, X, dprod);
#pragma unroll
        for (int kt = 0; kt < 4; ++kt)
#pragma unroll
            for (int e = 0; e < 16; ++e) E[((((size_t)item * 8 + wave) * 4 + kt) * 16 + e) * 64 + lane] = X[kt][e];
        if (tid < 128) Dg[item * 128 + tid] = dprod;
    }
}
__device__ __forceinline__ void p4_gla_pass2(const Params& p, LAS unsigned char* lds) {
    using namespace gla2;
    const int tid = threadIdx.x, lane = tid & 63, wave = __builtin_amdgcn_readfirstlane(tid >> 6), hh = lane >> 5;
    const float* E = (const float*)(p.ws + WS_GLAE); const float* Dg = (const float*)(p.ws + WS_GLAD);
    for (int item = blockIdx.x; item < NITEMS; item += gridDim.x) {
        const int bh = item / NSEG, seg = item - bh * NSEG;
        f32x16 X[4];
#pragma unroll
        for (int kt = 0; kt < 4; ++kt)
#pragma unroll
            for (int e = 0; e < 16; ++e) X[kt][e] = 0.f;
        for (int sp = 0; sp < seg; ++sp) { const int it = bh * NSEG + sp;
#pragma unroll
            for (int kt = 0; kt < 4; ++kt)
#pragma unroll
                for (int g4 = 0; g4 < 4; ++g4) { const f32x4 dv = *(const f32x4*)(Dg + it * 128 + 32 * kt + 8 * g4 + 4 * hh);
#pragma unroll
                    for (int e = 0; e < 4; ++e) X[kt][4 * g4 + e] = X[kt][4 * g4 + e] * dv[e] + E[((((size_t)it * 8 + wave) * 4 + kt) * 16 + 4 * g4 + e) * 64 + lane]; } }
        float dummy = 1.f;
        gla_run<true>(p, lds, bh >> 2, bh & 3, seg * LSEG, (seg + 1) * LSEG, X, dummy);
    }
}

__device__ __forceinline__ void p9_final(const Params& p) {
    const int tid = threadIdx.x, lane = tid & 63, wave = tid >> 6;
    const int gw = blockIdx.x * 8 + wave, NGW = gridDim.x * 8;
    const f32x4* gr = (const f32x4*)(p.in[I_FINN]) + lane;
    for (int m = gw; m < T; m += NGW) { f32x4* xr = (f32x4*)(p.out + (size_t)m * D) + lane; f32x4 v[4]; float s = 0.f;
#pragma unroll
        for (int j = 0; j < 4; ++j) { v[j] = xr[64 * j]; s += (v[j][0] * v[j][0] + v[j][1] * v[j][1]) + (v[j][2] * v[j][2] + v[j][3] * v[j][3]); }
        const float rs = 1.0f / sqrtf(wave_sum(s) * (1.0f / D) + EPS);
#pragma unroll
        for (int j = 0; j < 4; ++j) xr[64 * j] = v[j] * rs * gr[64 * j]; }
}

__global__ void __launch_bounds__(NTHREADS, 2) mega_fwd(Params p) {
    extern __shared__ __attribute__((aligned(16))) unsigned char lds_raw[];
    LAS unsigned char* lds = (LAS unsigned char*)lds_raw;
    cg::grid_group grid = cg::this_grid();
    unsigned char* ws = p.ws;
    const int G = gridDim.x, c = blockIdx.x;
    const int lo = p.ph_lo, hi = p.ph_hi;
#define IN(k) (lo <= (k) && (k) < hi)
    volatile LAS unsigned* xb_st = (volatile LAS unsigned*)(lds + 140 * 1024);
    if (threadIdx.x < 2) xb_st[threadIdx.x] = 0u;
    unsigned* xb_words = (unsigned*)(ws + WS_XBAR);
    if (blockIdx.x == 0) for (int i = threadIdx.x; i < XCD_BAR_WORDS; i += NTHREADS) xb_words[i] = 0u;
    if (blockIdx.x == 0 && threadIdx.x < 8) ((unsigned*)(ws + WS_GQ))[threadIdx.x] = 0u;
    __syncthreads();
    XcdBarrier xbar; xbar.bar = xb_words; xbar.x = 0; xbar.st = xb_st;
#define GRID_BARRIER() xcd_barrier(xbar)
#define SEAM(k) do { if (IN(k) && IN((k) + 1)) { if ((k) == 0) { grid.sync(); xbar = xcd_barrier_post(xb_words, xb_st); } else GRID_BARRIER(); } } while (0)
    if (IN(0)) p0_prep(p, lds);
    SEAM(0);
    if (IN(1)) {
        pg8::Gemm g{(const bf16_t*)(ws + WS_XB), nullptr, (const bf16_t*)(ws + WS_W1IN), nullptr, D, D, D, 1}; pg8::Order S; S.init(T, 2 * DFF, G, c, 1);
        pg8::EpiSwiGLU E{(const float*)(ws + WS_RS0), nullptr, (bf16_t*)(ws + WS_H)};
        pg8::gemm_phase(lds, g, S, E);
    }
    SEAM(1);
    if (IN(2)) {
        pg8::Gemm g{(const bf16_t*)(ws + WS_H), nullptr, (const bf16_t*)(ws + WS_W1OUT), nullptr, DFF, DFF, DFF, 1}; pg8::Order S; S.init(T, D, G, c, 1, true);
        pg8::EpiResid<false, true> E{(const bf16_t*)(ws + WS_XB), 0.5f, nullptr, (bf16_t*)(ws + WS_XB), (float*)(ws + WS_SSQ1)};
        pg8::gemm_phase(lds, g, S, E);
    }
    SEAM(2);
    if (IN(3)) {
        pg8::Gemm g{(const bf16_t*)(ws + WS_XB), nullptr, (const bf16_t*)(ws + WS_WIN), nullptr, D, D, D, 1}; pg8::Order S; S.init(T, NWIN, G, c, 1, false, true);
        pg8::EpiWin E{(const float*)(ws + WS_SSQ1), (bf16_t*)(ws + WS_U), (bf16_t*)(ws + WS_V), (bf16_t*)(ws + WS_Q), (bf16_t*)(ws + WS_K), (bf16_t*)(ws + WS_VB), (bf16_t*)(ws + WS_R), (bf16_t*)p.out, (bf16_t*)(ws + WS_LA),
                      (float*)(ws + WS_LNST), p.in[I_BGATE], p.in[I_BBA]};
        pg8::gemm_phase(lds, g, S, E);
    }
    SEAM(3);
    if (IN(4)) {
        p4_gmlp3(p, lds, (unsigned*)(ws + WS_GQ));
        p4_gla_pass1(p, lds);
        GRID_BARRIER();
        p4_gla_pass2(p, lds);
    }
    SEAM(4);
    if (IN(5)) {
        pg8::Gemm g{(const bf16_t*)(ws + WS_U), (const bf16_t*)(ws + WS_R), (const bf16_t*)(ws + WS_WPA), (const bf16_t*)(ws + WS_WPB), D, D, D, 1}; pg8::Order S; S.init(T, D, G, c, 2);
        pg8::EpiProj E{(const bf16_t*)p.out, (bf16_t*)(ws + WS_V)};
        pg8::gemm_phase(lds, g, S, E);
    }
    SEAM(5);
    if (IN(6)) {
        pg8::Gemm g{(const bf16_t*)(ws + WS_V), nullptr, (const bf16_t*)(ws + WS_WO), nullptr, D, D, D, 1}; pg8::Order S; S.init(T, D, G, c, 1);
        pg8::EpiResid<false, true> E{(const bf16_t*)(ws + WS_XB), 1.0f, nullptr, (bf16_t*)(ws + WS_X2B), (float*)(ws + WS_SSQ2)};
        pg8::gemm_phase(lds, g, S, E);
    }
    SEAM(6);
    if (IN(7)) {
        pg8::Gemm g{(const bf16_t*)(ws + WS_X2B), nullptr, (const bf16_t*)(ws + WS_W2IN), nullptr, D, D, D, 1}; pg8::Order S; S.init(T, 2 * DFF, G, c, 1);
        pg8::EpiSwiGLU E{nullptr, (const float*)(ws + WS_SSQ2), (bf16_t*)(ws + WS_H2)};
        pg8::gemm_phase(lds, g, S, E);
    }
    SEAM(7);
    if (IN(8)) {
        pg8::Gemm g{(const bf16_t*)(ws + WS_H2), nullptr, (const bf16_t*)(ws + WS_W2OUT), nullptr, DFF, DFF, DFF, 1}; pg8::Order S; S.init(T, D, G, c, 1, true);
        pg8::EpiResid<true, false> E{(const bf16_t*)(ws + WS_X2B), 0.5f, p.out, nullptr, nullptr};
        pg8::gemm_phase(lds, g, S, E);
    }
    SEAM(8);
    if (IN(9)) p9_final(p);
#undef IN
#undef SEAM
#undef GRID_BARRIER
}

extern "C" void kernel_launch(void* const* d_in, const int* in_sizes, int n_in, void* d_out, int out_size, void* d_ws, size_t ws_size, hipStream_t stream) {
    static int grid = 0;
    if (grid == 0) {
        int dev = 0, cus = 0, per_cu = 0;
        (void)hipGetDevice(&dev);
        (void)hipDeviceGetAttribute(&cus, hipDeviceAttributeMultiprocessorCount, dev);
        (void)hipFuncSetAttribute((const void*)mega_fwd, hipFuncAttributeMaxDynamicSharedMemorySize, LDS_BYTES);
        (void)hipOccupancyMaxActiveBlocksPerMultiprocessor(&per_cu, (const void*)mega_fwd, NTHREADS, LDS_BYTES);
        if (per_cu < 1) { fprintf(stderr, "kernel_launch: occupancy query says %d blocks/CU\n", per_cu); per_cu = 1; }
        grid = cus;
        if (n_in != 21 || out_size != T * D || ws_size < WS_END) fprintf(stderr, "kernel_launch: unexpected sizes n_in %d out %d ws %zu\n", n_in, out_size, ws_size);
        fprintf(stderr, "kernel_launch: cus %d per_cu %d grid %d ws %zu\n", cus, per_cu, grid, ws_size);
    }
    Params p{};
    for (int i = 0; i < 21; ++i) p.in[i] = (const float*)d_in[i];
    p.out = (float*)d_out; p.ws = (unsigned char*)d_ws; p.ph_lo = 0; p.ph_hi = 10;
    void* args[] = {&p};
    hipError_t e = hipLaunchCooperativeKernel((const void*)mega_fwd, dim3(grid), dim3(NTHREADS), args, LDS_BYTES, stream);
    if (e != hipSuccess) fprintf(stderr, "cooperative launch failed: %s (grid %d)\n", hipGetErrorString(e), grid);
}
```

```cpp
#include <hip/hip_runtime.h>
#include <hip/hip_cooperative_groups.h>
#include <cstdio>
#include <cstdint>
namespace cg = cooperative_groups;

#define LAS __attribute__((address_space(3)))
typedef unsigned short bf16_t;
typedef short bf16x8 __attribute__((ext_vector_type(8)));
typedef float f32x4 __attribute__((ext_vector_type(4)));
typedef float f32x2 __attribute__((ext_vector_type(2)));
typedef unsigned u32x4 __attribute__((ext_vector_type(4)));
typedef unsigned u32x2 __attribute__((ext_vector_type(2)));
typedef float f32x8 __attribute__((ext_vector_type(8)));
typedef float f32x16 __attribute__((ext_vector_type(16)));
typedef __bf16 bf16x8_t __attribute__((ext_vector_type(8)));
typedef __bf16 bf16x2_t __attribute__((ext_vector_type(2)));

constexpr int T = 65536, D = 1024, DFF = 2816, SEQ = 8192;
constexpr int NWIN = 7680;
constexpr float EPS = 1e-6f;
constexpr int NTHREADS = 512;
constexpr int LDS_BYTES = 147456;

constexpr size_t MiB = (size_t)1 << 20;
constexpr size_t WS_GQ = 128;
constexpr size_t WS_XBAR = 64 * 1024;
constexpr size_t WS_RS0 = 1 * MiB;
constexpr size_t WS_SSQ1 = 2 * MiB;
constexpr size_t WS_SSQ2 = 6 * MiB;
constexpr size_t WS_LNST = 10 * MiB;
constexpr size_t WS_W1IN = 20 * MiB, WS_W1OUT = 31 * MiB, WS_WIN = 37 * MiB, WS_WPA = 52 * MiB, WS_WPB = 54 * MiB, WS_WO = 56 * MiB, WS_W2IN = 58 * MiB, WS_W2OUT = 69 * MiB;
constexpr size_t ACT0 = 76 * MiB;
constexpr size_t WS_XB = ACT0;
constexpr size_t WS_H = ACT0 + 128 * MiB;
constexpr size_t WS_U = ACT0 + 128 * MiB;
constexpr size_t WS_V = ACT0 + 256 * MiB;
constexpr size_t WS_Q = ACT0 + 384 * MiB;
constexpr size_t WS_K = ACT0 + 448 * MiB;
constexpr size_t WS_VB = ACT0 + 512 * MiB;
constexpr size_t WS_R = ACT0 + 640 * MiB;
constexpr size_t WS_LA = ACT0 + 768 * MiB;
constexpr size_t WS_X2B = ACT0 + 128 * MiB;
constexpr size_t WS_H2 = ACT0 + 256 * MiB;
constexpr size_t WS_GLAE = ACT0 + 832 * MiB;
constexpr size_t WS_GLAD = ACT0 + 864 * MiB;
constexpr size_t WS_END = ACT0 + 896 * MiB;
static_assert(WS_END <= 1024 * MiB, "ws map");

__device__ __forceinline__ unsigned f2bf(float f) { unsigned u = __builtin_bit_cast(unsigned, f); return (u + 0x7fffu + ((u >> 16) & 1u)) >> 16; }
__device__ __forceinline__ unsigned pk2(float lo, float hi) { return f2bf(lo) | (f2bf(hi) << 16); }
__device__ __forceinline__ float bf2f(unsigned short b) { return __builtin_bit_cast(float, ((unsigned)b) << 16); }
__device__ __forceinline__ float bflo(unsigned w) { return __builtin_bit_cast(float, w << 16); }
__device__ __forceinline__ float bfhi(unsigned w) { return __builtin_bit_cast(float, w & 0xffff0000u); }
__device__ __forceinline__ float wave_sum(float v) {
#pragma unroll
    for (int o = 1; o < 64; o <<= 1) v += __shfl_xor(v, o);
    return v;
}

__device__ __forceinline__ bf16x8 cvt8(f32x8 v) { return __builtin_bit_cast(bf16x8, __builtin_convertvector(v, bf16x8_t)); }
__device__ __forceinline__ unsigned cvt2(float a, float b) { const f32x2 v = {a, b}; return __builtin_bit_cast(unsigned, __builtin_convertvector(v, bf16x2_t)); }

namespace pg8 {
constexpr int BM = 256, BK = 64, HALF = 128, HTB = HALF * BK * 2, STAGE_BYTES = 8 * HTB, NXCD = 8, WGM = 8;
__host__ __device__ __forceinline__ int lds_byte(int r, int c) { const int st = (r >> 4) * 2 + (c >> 5), rr = r & 15, cc = c & 31, ob = rr * 64 + cc * 2; return st * 1024 + (ob ^ (((ob >> 9) & 1) << 5)); }
__host__ __device__ __forceinline__ void stage_rc(int b, int& R, int& C) { const int st = b / 1024, sb = b % 1024, swz = sb ^ (((sb >> 9) & 1) << 5); R = (st >> 1) * 16 + swz / 64; C = (st & 1) * 32 + (swz % 64) / 2; }
__host__ __device__ __forceinline__ int perm32(int rho) { const int n = rho >> 4, i = rho & 15; return 8 * (i >> 2) + 4 * n + (i & 3); }

struct Unit { int pm, pn, seg; };
struct Gemm { const bf16_t *A0, *A1, *B0, *B1; int lda, ldb, K, nsh; };
__device__ __forceinline__ const char* a_ptr(const Gemm& g, const Unit& u) { const bool s = u.seg >= g.nsh; const bf16_t* b = s ? g.A1 : g.A0; const int ks = s ? u.seg - g.nsh : u.seg; return (const char*)(b + (size_t)u.pm * BM * g.lda + ks * g.K); }
__device__ __forceinline__ const char* b_ptr(const Gemm& g, const Unit& u) { const bool s = u.seg >= g.nsh; const bf16_t* b = s ? g.B1 : g.B0; const int ks = s ? u.seg - g.nsh : u.seg; return (const char*)(b + (size_t)u.pn * BM * g.ldb + ks * g.K); }

struct Order {
    int nM, nN, nwg, G, c, nseg, nper, revn;
    __device__ void init(int M, int N, int G_, int c_, int nseg_, bool rev = false, bool revn_ = false) { nM = M / BM; nN = N / BM; nwg = nM * nN; G = G_; c = c_; nseg = nseg_; nper = rev ? (nwg - c + G - 1) / G : 0; revn = revn_ ? 1 : 0; }
    __device__ bool next(int i, Unit& u) const {
        int ti = i / nseg; u.seg = i - ti * nseg;
        if (nper > 0) { if (ti >= nper) return false; ti = nper - 1 - ti; }
        const long L = (long)ti * G + c; if (L >= nwg) return false;
        int wgid = (int)L; { const int q = nwg / NXCD, r = nwg % NXCD, xcd = wgid % NXCD, off = wgid / NXCD; wgid = (xcd < r ? xcd * (q + 1) : r * (q + 1) + (xcd - r) * q) + off; }
        const int nig = WGM * nN, gid = wgid / nig, fm = gid * WGM, gsz = (nM - fm) < WGM ? (nM - fm) : WGM;
        u.pm = fm + ((wgid % nig) % gsz); u.pn = (wgid % nig) / gsz; if (revn) u.pn = nN - 1 - u.pn; return true;
    }
};

__device__ __forceinline__ unsigned cvt_pk_bf16(float lo, float hi) { unsigned r; asm volatile("v_cvt_pk_bf16_f32 %0, %1, %2" : "=v"(r) : "v"(lo), "v"(hi)); return r; }
__device__ __forceinline__ f32x2 gelu_pk(f32x2 v) {
    const f32x2 av = __builtin_elementwise_abs(v), d = av * 0.2316418882f + 1.0f;
    f32x2 t; t.x = __builtin_amdgcn_rcpf(d.x); t.y = __builtin_amdgcn_rcpf(d.y);
    f32x2 q = t * 0.5307027145f + (-0.7265760135f); q = q * t + 0.7107068705f; q = q * t + (-0.142248368f); q = q * t + 0.127414796f; q = q * t;
    const f32x2 s = (v * v) * (-0.72134752044f);
    f32x2 e; e.x = __builtin_amdgcn_exp2f(s.x); e.y = __builtin_amdgcn_exp2f(s.y);
    const f32x2 m = v * (q * e), r = v - m;
    f32x2 o; o.x = v.x < 0.f ? m.x : r.x; o.y = v.y < 0.f ? m.y : r.y; return o;
}
__device__ __forceinline__ f32x4 gelu4(f32x4 v) { const f32x2 a = gelu_pk((f32x2){v[0], v[1]}), b = gelu_pk((f32x2){v[2], v[3]}); return (f32x4){a.x, a.y, b.x, b.y}; }
__device__ __forceinline__ f32x4 ex2n4(f32x4 v) { const f32x4 t = v * (-1.4426950408889634f); return (f32x4){__builtin_amdgcn_exp2f(t[0]), __builtin_amdgcn_exp2f(t[1]), __builtin_amdgcn_exp2f(t[2]), __builtin_amdgcn_exp2f(t[3])}; }
__device__ __forceinline__ f32x4 rcp4(f32x4 v) { return (f32x4){__builtin_amdgcn_rcpf(v[0]), __builtin_amdgcn_rcpf(v[1]), __builtin_amdgcn_rcpf(v[2]), __builtin_amdgcn_rcpf(v[3])}; }
__device__ __forceinline__ f32x4 sigm4(f32x4 v) { return rcp4(ex2n4(v) + 1.0f); }
__device__ __forceinline__ f32x4 silu4(f32x4 v) { return v * sigm4(v); }
__device__ __forceinline__ f32x4 lsig4(f32x4 v) {
    const f32x4 e = ex2n4(__builtin_elementwise_abs(v)) + 1.0f;
    const f32x4 l = {__builtin_amdgcn_logf(e[0]), __builtin_amdgcn_logf(e[1]), __builtin_amdgcn_logf(e[2]), __builtin_amdgcn_logf(e[3])};
    return (__builtin_elementwise_min(v, (f32x4){0.f, 0.f, 0.f, 0.f}) * 1.4426950408889634f - l) * 0.0625f;
}
__device__ __forceinline__ u32x4 pack8(f32x4 v0, f32x4 v1) { u32x4 w; w.x = cvt_pk_bf16(v0[0], v0[1]); w.y = cvt_pk_bf16(v0[2], v0[3]); w.z = cvt_pk_bf16(v1[0], v1[1]); w.w = cvt_pk_bf16(v1[2], v1[3]); return w; }
__device__ __forceinline__ void unpack8(u32x4 w, f32x4& v0, f32x4& v1) { v0 = (f32x4){bflo(w.x), bfhi(w.x), bflo(w.y), bfhi(w.y)}; v1 = (f32x4){bflo(w.z), bfhi(w.z), bflo(w.w), bfhi(w.w)}; }
__device__ __forceinline__ void rows_rs16(const float* ssq, int row0, int fq, float sc, float (&rsv)[2][4]) {
    f32x4 sv[2][4];
#pragma unroll
    for (int ai = 0; ai < 2; ++ai)
#pragma unroll
        for (int m = 0; m < 4; ++m) sv[ai][m] = *(const f32x4*)(ssq + (size_t)(row0 + ai * 128 + m * 16) * 16 + 4 * fq);
#pragma unroll
    for (int ai = 0; ai < 2; ++ai)
#pragma unroll
        for (int m = 0; m < 4; ++m) { float s = (sv[ai][m][0] + sv[ai][m][1]) + (sv[ai][m][2] + sv[ai][m][3]);
            s += __shfl_xor(s, 16); s += __shfl_xor(s, 32);
            rsv[ai][m] = __builtin_amdgcn_rsqf(s * (1.0f / 1024.0f) + EPS) * sc; }
}

__device__ __forceinline__ void rs_table_fill(LAS float* tab, const float* direct, const float* ssq, int pm, int tid) {
    const int row = tid >> 1, half = tid & 1; const size_t grow = (size_t)pm * 256 + row;
    if (direct) { if (half == 0) tab[row] = direct[grow]; }
    else { const f32x4 v0 = *(const f32x4*)(ssq + grow * 16 + 8 * half), v1 = *(const f32x4*)(ssq + grow * 16 + 8 * half + 4);
        float t = ((v0[0] + v0[1]) + (v0[2] + v0[3])) + ((v1[0] + v1[1]) + (v1[2] + v1[3])); t += __shfl_xor(t, 1);
        if (half == 0) tab[row] = __builtin_amdgcn_rsqf(t * (1.0f / 1024.0f) + EPS); }
}

typedef f32x4 Acc[2][2][4][2];

struct EpiSwiGLU {
    const float* rs_direct;
    const float* ssq;
    bf16_t* H;
    __device__ __forceinline__ bool keep(const Unit&) const { return false; }
    static constexpr bool USES_RS = true;
    __device__ __forceinline__ void run_rs(Acc& acc, const Unit& u, int wr, int wc, int fr, int fq, const LAS float* rs_tab) const {
        const int row0 = u.pm * BM + wr * 64 + fr, col0 = u.pn * 128 + wc * 32 + 8 * fq;
        float rsv[2][4];
#pragma unroll
        for (int ai = 0; ai < 2; ++ai)
#pragma unroll
            for (int m = 0; m < 4; ++m) rsv[ai][m] = rs_tab[ai * HALF + wr * 64 + m * 16 + fr];
#pragma unroll
        for (int ai = 0; ai < 2; ++ai)
#pragma unroll
            for (int m = 0; m < 4; ++m) { const int row = row0 + ai * HALF + m * 16;
                const float rs = rsv[ai][m];
                const f32x4 a0 = acc[ai][0][m][0] * rs, a1 = acc[ai][0][m][1] * rs, b0 = acc[ai][1][m][0] * rs, b1 = acc[ai][1][m][1] * rs;
                *(u32x4*)(H + (size_t)row * DFF + col0) = pack8(silu4(a0) * b0, silu4(a1) * b1); }
    }
};
template <bool OUT_F32, bool OUT_BF16> struct EpiResid {
    static constexpr bool USES_RS = false;
    const bf16_t* base; float scale; float* of32; bf16_t* obf; float* ssq;
    __device__ __forceinline__ bool keep(const Unit&) const { return false; }
    __device__ __forceinline__ void operator()(Acc& acc, const Unit& u, int wr, int wc, int fr, int fq) const {
        const int row0 = u.pm * BM + wr * 64 + fr, col0 = u.pn * BM + wc * 32 + 8 * fq;
        u32x4 bw[2][4][2];
#pragma unroll
        for (int ai = 0; ai < 2; ++ai)
#pragma unroll
            for (int m = 0; m < 4; ++m)
#pragma unroll
                for (int bj = 0; bj < 2; ++bj) bw[ai][m][bj] = *(const u32x4*)(base + (size_t)(row0 + ai * HALF + m * 16) * D + col0 + bj * HALF);
#pragma unroll
        for (int ai = 0; ai < 2; ++ai)
#pragma unroll
            for (int m = 0; m < 4; ++m) { const int row = row0 + ai * HALF + m * 16; const size_t off = (size_t)row * D + col0; float q = 0.f;
#pragma unroll
                for (int bj = 0; bj < 2; ++bj) { f32x4 b0, b1; unpack8(bw[ai][m][bj], b0, b1);
                    const f32x4 v0 = b0 + acc[ai][bj][m][0] * scale, v1 = b1 + acc[ai][bj][m][1] * scale;
                    q += (v0[0] * v0[0] + v0[1] * v0[1]) + (v0[2] * v0[2] + v0[3] * v0[3]) + (v1[0] * v1[0] + v1[1] * v1[1]) + (v1[2] * v1[2] + v1[3] * v1[3]);
                    if (OUT_F32) { *(f32x4*)(of32 + off + bj * HALF) = v0; *(f32x4*)(of32 + off + bj * HALF + 4) = v1; }
                    if (OUT_BF16) *(u32x4*)(obf + off + bj * HALF) = pack8(v0, v1); }
                q += __shfl_xor(q, 16); q += __shfl_xor(q, 32);
                if (ssq && fq == 0) ssq[(size_t)row * 16 + 4 * u.pn + wc] = q; }
    }
};
struct EpiWin {
    const float* ssq; bf16_t *U, *V, *Q, *Kb, *VB, *R, *G, *LA; float* lnst; const float *b_gate, *b_alpha;
    __device__ __forceinline__ bool keep(const Unit&) const { return false; }
    static constexpr bool USES_RS = true; static constexpr const float* rs_direct = nullptr;
    __device__ __forceinline__ void run_rs(Acc& acc, const Unit& u, int wr, int wc, int fr, int fq, const LAS float* rs_tab) const {
        const int pn = u.pn; int kind, ld, colt; bf16_t* basep; const float* bias = nullptr; float sc = 1.f; bool stats = false;
        if (pn < 4) { kind = 1; basep = U; ld = 1024; colt = 256 * pn; }
        else if (pn < 8) { kind = 1; basep = V; ld = 1024; colt = 256 * (pn - 4); stats = true; }
        else if (pn < 10) { kind = 0; basep = Q; ld = 512; colt = 256 * (pn - 8); sc = 0.08838834764831845f; }
        else if (pn < 12) { kind = 0; basep = Kb; ld = 512; colt = 256 * (pn - 10); }
        else if (pn < 16) { kind = 0; basep = VB; ld = 1024; colt = 256 * (pn - 12); }
        else if (pn < 20) { kind = 2; basep = R; ld = 1024; colt = 256 * (pn - 16); }
        else if (pn < 28) { kind = 3; basep = G; ld = 2048; colt = 256 * (pn - 20); bias = b_gate; }
        else { kind = 4; basep = LA; ld = 512; colt = 256 * (pn - 28); bias = b_alpha; }
        const int row0 = u.pm * BM + wr * 64 + fr, col0 = colt + wc * 32 + 8 * fq;
        f32x4 bv[2][2];
        if (bias) {
#pragma unroll
            for (int bj = 0; bj < 2; ++bj)
#pragma unroll
                for (int n = 0; n < 2; ++n) bv[bj][n] = *(const f32x4*)(bias + col0 + bj * HALF + 4 * n); }
        float rsv[2][4];
#pragma unroll
        for (int ai = 0; ai < 2; ++ai)
#pragma unroll
            for (int m = 0; m < 4; ++m) rsv[ai][m] = rs_tab[ai * HALF + wr * 64 + m * 16 + fr] * sc;
#pragma unroll
        for (int ai = 0; ai < 2; ++ai)
#pragma unroll
            for (int m = 0; m < 4; ++m) { const int row = row0 + ai * HALF + m * 16; const float rs = rsv[ai][m]; float s1 = 0.f, s2 = 0.f;
                bf16_t* rowp = basep + (size_t)row * ld + col0;
#pragma unroll
                for (int bj = 0; bj < 2; ++bj) { f32x4 v0 = acc[ai][bj][m][0] * rs, v1 = acc[ai][bj][m][1] * rs;
                    if (bias) { v0 += bv[bj][0]; v1 += bv[bj][1]; }
                    if (kind == 1) { v0 = gelu4(v0); v1 = gelu4(v1); }
                    else if (kind == 2) { v0 = silu4(v0); v1 = silu4(v1); }
                    else if (kind == 3) { v0 = sigm4(v0); v1 = sigm4(v1); }
                    else if (kind == 4) { v0 = lsig4(v0); v1 = lsig4(v1); }
                    if (stats) { s1 += (v0[0] + v0[1]) + (v0[2] + v0[3]) + (v1[0] + v1[1]) + (v1[2] + v1[3]);
                        s2 += (v0[0] * v0[0] + v0[1] * v0[1]) + (v0[2] * v0[2] + v0[3] * v0[3]) + (v1[0] * v1[0] + v1[1] * v1[1]) + (v1[2] * v1[2] + v1[3] * v1[3]); }
                    if (pn < 8) *(u32x4*)(rowp + bj * HALF) = pack8(v0, v1); else __builtin_nontemporal_store(pack8(v0, v1), (u32x4*)(rowp + bj * HALF)); }
                if (stats) { s1 += __shfl_xor(s1, 16); s1 += __shfl_xor(s1, 32); s2 += __shfl_xor(s2, 16); s2 += __shfl_xor(s2, 32);
                    if (fq == 0) *(f32x2*)(lnst + ((size_t)row * 16 + 4 * (pn - 4) + wc) * 2) = (f32x2){s1, s2}; } }
    }
};
struct EpiProj {
    static constexpr bool USES_RS = false;
    const bf16_t* G; bf16_t* Mb;
    __device__ __forceinline__ bool keep(const Unit& u) const { return u.seg == 0; }
    __device__ __forceinline__ void operator()(Acc& acc, const Unit& u, int wr, int wc, int fr, int fq) const {
        const int row0 = u.pm * BM + wr * 64 + fr, col0 = u.pn * BM + wc * 32 + 8 * fq;
        if (u.seg == 0) {
#pragma unroll
            for (int ai = 0; ai < 2; ++ai)
#pragma unroll
                for (int m = 0; m < 4; ++m)
#pragma unroll
                    for (int bj = 0; bj < 2; ++bj) { const bf16_t* gp = G + (size_t)(row0 + ai * HALF + m * 16) * 2048 + col0 + bj * HALF;
                        f32x4 sa0, sa1, sb0, sb1; unpack8(*(const u32x4*)gp, sa0, sa1); unpack8(*(const u32x4*)(gp + 1024), sb0, sb1);
#pragma unroll
                        for (int e = 0; e < 4; ++e) { acc[ai][bj][m][0][e] *= sa0[e] * __builtin_amdgcn_rcpf(fmaxf(sb0[e], 1e-30f)); acc[ai][bj][m][1][e] *= sa1[e] * __builtin_amdgcn_rcpf(fmaxf(sb1[e], 1e-30f)); } }
        } else {
            u32x4 gw[2][4][2];
#pragma unroll
            for (int ai = 0; ai < 2; ++ai)
#pragma unroll
                for (int m = 0; m < 4; ++m)
#pragma unroll
                    for (int bj = 0; bj < 2; ++bj) gw[ai][m][bj] = *(const u32x4*)(G + (size_t)(row0 + ai * HALF + m * 16) * 2048 + 1024 + col0 + bj * HALF);
#pragma unroll
            for (int ai = 0; ai < 2; ++ai)
#pragma unroll
                for (int m = 0; m < 4; ++m)
#pragma unroll
                    for (int bj = 0; bj < 2; ++bj) { f32x4 sb0, sb1; unpack8(gw[ai][m][bj], sb0, sb1);
                        *(u32x4*)(Mb + (size_t)(row0 + ai * HALF + m * 16) * D + col0 + bj * HALF) = pack8(acc[ai][bj][m][0] * sb0, acc[ai][bj][m][1] * sb1); }
        }
    }
};

template <class Epi>
__device__ __forceinline__ void gemm_phase(LAS unsigned char* lds, const Gemm g, const Order& S, const Epi& E) {
    const int tid = threadIdx.x, wid = __builtin_amdgcn_readfirstlane(tid >> 6), lane = tid & 63, wr = wid >> 2, wc = wid & 3, fr = lane & 15, fq = lane >> 4;
    const int nt = g.K / BK;
    unsigned voffA[2], voffB[2];
#pragma unroll
    for (int i = 0; i < 2; ++i) { int R, C; stage_rc(tid * 16 + i * 8192, R, C); const int Rb = (R & ~31) + perm32(R & 31);
        voffA[i] = (unsigned)(R * g.lda + C) * 2u; voffB[i] = (unsigned)(Rb * g.ldb + C) * 2u; }
    const size_t kstep = (size_t)(BK * 2);
    const size_t hstepA = (size_t)HALF * g.lda * 2, hstepB = (size_t)HALF * g.ldb * 2;
    const unsigned ldsw = (unsigned)wid * 1024u;
    const int aoff = lds_byte(wr * 64 + fr, fq * 8), boff = lds_byte(wc * 32 + fr, fq * 8);
#define PG8_SA(b, h) (((b) * 2 + (h)) * HTB)
#define PG8_SB(b, h) ((4 + (b) * 2 + (h)) * HTB)
#define PG8_STAGE(bufoff, gbase, voff) do { _Pragma("unroll") for (int _i = 0; _i < 2; ++_i) \
        __builtin_amdgcn_global_load_lds((const unsigned*)((const char*)(gbase) + (voff)[_i]), (LAS unsigned*)(lds + (bufoff) + ldsw + _i * 8192), 16, 0, 0); } while (0)
#define PG8_LDA(dst, b, h) do { _Pragma("unroll") for (int m = 0; m < 4; ++m) _Pragma("unroll") for (int k = 0; k < 2; ++k) dst[m][k] = *(const LAS bf16x8*)(lds + PG8_SA(b, h) + aoff + m * 2048 + k * 1024); } while (0)
#define PG8_LDB(dst, b, h) do { _Pragma("unroll") for (int n = 0; n < 2; ++n) _Pragma("unroll") for (int k = 0; k < 2; ++k) dst[n][k] = *(const LAS bf16x8*)(lds + PG8_SB(b, h) + boff + n * 2048 + k * 1024); } while (0)
#define PG8_MMA(ai, bj, At, Bt) do { __builtin_amdgcn_s_setprio(1); _Pragma("unroll") for (int m = 0; m < 4; ++m) _Pragma("unroll") for (int n = 0; n < 2; ++n) _Pragma("unroll") for (int k = 0; k < 2; ++k) \
        acc[ai][bj][m][n] = __builtin_amdgcn_mfma_f32_16x16x32_bf16(Bt[n][k], At[m][k], acc[ai][bj][m][n], 0, 0, 0); __builtin_amdgcn_s_setprio(0); } while (0)
#define PG8_WAIT_V(n) asm volatile("s_waitcnt vmcnt(" #n ")" ::: "memory")
#define PG8_WAIT_L(n) asm volatile("s_waitcnt lgkmcnt(" #n ")" ::: "memory")
#define PG8_BAR __builtin_amdgcn_s_barrier()
#define PG8_SCHED __builtin_amdgcn_sched_barrier(0)
    Unit cur, nxt; int ui = 0;
    if (!S.next(0, cur)) return;
    Acc acc;
#pragma unroll
    for (int a = 0; a < 2; ++a)
#pragma unroll
        for (int b = 0; b < 2; ++b)
#pragma unroll
            for (int m = 0; m < 4; ++m)
#pragma unroll
                for (int n = 0; n < 2; ++n) acc[a][b][m][n] = (f32x4){0.f, 0.f, 0.f, 0.f};
    bf16x8 At[4][2], B0[2][2], B1[2][2];
    const char* cA = a_ptr(g, cur); const char* cB = b_ptr(g, cur);
    PG8_STAGE(PG8_SB(0, 0), cB, voffB); PG8_STAGE(PG8_SB(0, 1), cB + hstepB, voffB); PG8_STAGE(PG8_SA(0, 0), cA, voffA); PG8_STAGE(PG8_SA(0, 1), cA + hstepA, voffA);
    if (wr == 1) PG8_BAR;
    PG8_WAIT_V(2); PG8_BAR;
    PG8_STAGE(PG8_SB(1, 0), cB + kstep, voffB); PG8_STAGE(PG8_SA(1, 0), cA + kstep, voffA); PG8_STAGE(PG8_SB(1, 1), cB + hstepB + kstep, voffB);
    PG8_WAIT_V(6); PG8_BAR;
    int tab_pm = -1, tab_sel = 0;
    for (;;) {
        if constexpr (Epi::USES_RS) { if (cur.pm != tab_pm) { tab_pm = cur.pm; tab_sel ^= 1;
            rs_table_fill((LAS float*)(lds + 131072 + tab_sel * 1024), E.rs_direct, E.ssq, cur.pm, tid); } }
        const bool has_next = S.next(ui + 1, nxt);
        const char* nA = has_next ? a_ptr(g, nxt) : cA; const char* nB = has_next ? b_ptr(g, nxt) : cB;
        asm volatile(".p2align 8\n\ts_nop 0\n\ts_nop 0\n\ts_nop 0\n\ts_nop 0\n\ts_nop 0\n\ts_nop 0\n\ts_nop 0\n\ts_nop 0\n\ts_nop 0\n\ts_nop 0" ::: "memory");
        for (int t = 0; t < nt; t += 2) {
            const bool last = (t == nt - 2);
            const char* a1 = cA + (size_t)(t + 1) * kstep;
            const char* a2 = last ? nA : cA + (size_t)(t + 2) * kstep; const char* b2 = last ? nB : cB + (size_t)(t + 2) * kstep;
            const char* a3 = a2 + kstep; const char* b3 = b2 + kstep;
            PG8_LDB(B0, 0, 0); PG8_LDB(B1, 0, 1); PG8_SCHED; PG8_LDA(At, 0, 0); PG8_STAGE(PG8_SA(1, 1), a1 + hstepA, voffA);
            PG8_WAIT_V(8); PG8_WAIT_L(0); PG8_BAR; PG8_MMA(0, 0, At, B0); PG8_MMA(0, 1, At, B1); PG8_BAR; PG8_SCHED;
            PG8_LDA(At, 0, 1); PG8_STAGE(PG8_SB(0, 0), b2, voffB); PG8_STAGE(PG8_SB(0, 1), b2 + hstepB, voffB); PG8_STAGE(PG8_SA(0, 0), a2, voffA);
            PG8_WAIT_V(8); PG8_WAIT_L(0); PG8_BAR; PG8_MMA(1, 0, At, B0); PG8_MMA(1, 1, At, B1); PG8_BAR; PG8_SCHED;
            PG8_LDB(B0, 1, 0); PG8_LDB(B1, 1, 1); PG8_SCHED; PG8_LDA(At, 1, 0); PG8_STAGE(PG8_SA(0, 1), a2 + hstepA, voffA);
            PG8_WAIT_V(8); PG8_WAIT_L(0); PG8_BAR; PG8_MMA(0, 0, At, B0); PG8_MMA(0, 1, At, B1); PG8_BAR; PG8_SCHED;
            PG8_LDA(At, 1, 1); PG8_STAGE(PG8_SB(1, 0), b3, voffB); PG8_STAGE(PG8_SB(1, 1), b3 + hstepB, voffB); PG8_STAGE(PG8_SA(1, 0), a3, voffA);
            PG8_WAIT_V(8); PG8_WAIT_L(0); PG8_BAR; PG8_MMA(1, 0, At, B0); PG8_MMA(1, 1, At, B1); PG8_BAR; PG8_SCHED;
        }
        if (wr == 0) PG8_BAR;
        if constexpr (Epi::USES_RS) E.run_rs(acc, cur, wr, wc, fr, fq, (const LAS float*)(lds + 131072 + tab_sel * 1024)); else E(acc, cur, wr, wc, fr, fq);
        if (!has_next) break;
        if (!E.keep(cur)) {
#pragma unroll
            for (int a = 0; a < 2; ++a)
#pragma unroll
                for (int b = 0; b < 2; ++b)
#pragma unroll
                    for (int m = 0; m < 4; ++m)
#pragma unroll
                        for (int n = 0; n < 2; ++n) acc[a][b][m][n] = (f32x4){0.f, 0.f, 0.f, 0.f};
        }
        cur = nxt; cA = nA; cB = nB; ++ui;
        if (wr == 1) PG8_BAR;
    }
    PG8_WAIT_V(0);
    PG8_BAR;
#undef PG8_SA
#undef PG8_SB
#undef PG8_STAGE
#undef PG8_LDA
#undef PG8_LDB
#undef PG8_MMA
#undef PG8_WAIT_V
#undef PG8_WAIT_L
#undef PG8_BAR
#undef PG8_SCHED
}
}


#define XB_TMO      128
#define XB_XCNT(j)  (256  + 64 * (j))
#define XB_XSUB(j)  (1280 + 64 * (j))
#define XB_XGEN(j)  (2304 + 64 * (j))
#define XB_TOP      3328
#define XB_TOPGEN   3392
#define XCD_BAR_WORDS 3456
#define XB_SPIN_CAP (1u << 18)
__device__ __forceinline__ unsigned xb_ld(unsigned* p)              { return __hip_atomic_load(p, __ATOMIC_RELAXED, __HIP_MEMORY_SCOPE_AGENT); }
__device__ __forceinline__ unsigned xb_add(unsigned* p, unsigned v) { return __hip_atomic_fetch_add(p, v, __ATOMIC_RELAXED, __HIP_MEMORY_SCOPE_AGENT); }
__device__ __forceinline__ unsigned xb_xcc_id() { return (unsigned)__builtin_amdgcn_s_getreg((3 << 11) | 20) & 0xFu; }
#define XB_SPIN(cond, bar) do { unsigned _sp = 0; while (cond) { __builtin_amdgcn_s_sleep(1); \
    if ((++_sp & 255u) == 0u) { if (xb_ld(&(bar)[XB_TMO])) break; if (_sp > XB_SPIN_CAP) { atomicAdd(&(bar)[XB_TMO], 1u); break; } } } } while (0)
struct XcdBarrier { unsigned* bar; unsigned x; volatile LAS unsigned* st; };
__device__ __forceinline__ XcdBarrier xcd_barrier_post(unsigned* bar, volatile LAS unsigned* st) {
    XcdBarrier b; b.bar = bar; b.x = xb_xcc_id(); b.st = st;
    if (threadIdx.x == 0) (void)xb_add(&bar[XB_XCNT(b.x)], 1u);
    return b;
}
__device__ __forceinline__ void xcd_barrier_complete(unsigned* bar, unsigned x, unsigned& nloc, unsigned& nx) {
    const unsigned G = gridDim.x * gridDim.y * gridDim.z;
    unsigned sum, cnt, mine, sp = 0u;
    for (;;) {
        sum = 0u; cnt = 0u; mine = 0u;
#pragma unroll
        for (unsigned j = 0; j < 16; ++j) { const unsigned c = xb_ld(&bar[XB_XCNT(j)]); sum += c; cnt += (c > 0u) ? 1u : 0u; mine = (j == x) ? c : mine; }
        if (sum == G) break;
        __builtin_amdgcn_s_sleep(1);
        if ((++sp & 255u) == 0u) { if (xb_ld(&bar[XB_TMO])) break; if (sp > XB_SPIN_CAP) { atomicAdd(&bar[XB_TMO], 1u); break; } }
    }
    nloc = mine > 0u ? mine : 1u; nx = cnt > 0u ? cnt : 1u;
}
__device__ __forceinline__ void xcd_barrier(const XcdBarrier& b) {
    asm volatile("s_waitcnt vmcnt(0)" ::: "memory");
    __syncthreads();
    if (threadIdx.x == 0) {
        unsigned* bar = b.bar;
        __builtin_amdgcn_s_waitcnt(0);
        unsigned nloc = b.st[0], nx = b.st[1];
        if (nloc == 0u) { xcd_barrier_complete(bar, b.x, nloc, nx); b.st[0] = nloc; b.st[1] = nx; }
        const unsigned old = xb_add(&bar[XB_XSUB(b.x)], 1u);
        const unsigned gen = old / nloc;
        if (old + 1u == (gen + 1u) * nloc) {
            __builtin_amdgcn_fence(__ATOMIC_RELEASE, "agent");
            asm volatile("s_waitcnt vmcnt(0)" ::: "memory");
            const unsigned og = xb_add(&bar[XB_TOP], 1u);
            const unsigned tg = og / nx;
            if (og + 1u == (tg + 1u) * nx) xb_add(&bar[XB_TOPGEN], 1u);
            else XB_SPIN(xb_ld(&bar[XB_TOPGEN]) == tg, bar);
            __builtin_amdgcn_fence(__ATOMIC_ACQUIRE, "agent");
            xb_add(&bar[XB_XGEN(b.x)], 1u);
            asm volatile("s_waitcnt vmcnt(0)" ::: "memory");
        } else {
            XB_SPIN(xb_ld(&bar[XB_XGEN(b.x)]) == gen, bar);
            __builtin_amdgcn_fence(__ATOMIC_ACQUIRE, "agent");
            asm volatile("s_waitcnt vmcnt(0)" ::: "memory");
        }
    }
    __syncthreads();
}

struct Params {
    const float* in[21];
    float* out;
    unsigned char* ws;
    int ph_lo, ph_hi;
};
enum { I_X = 0, I_F1N, I_F1WI, I_F1WO, I_MIXN, I_WIN, I_BGATE, I_ALNG, I_ALNB, I_AWS, I_ABS, I_BWA, I_BBA, I_BHN, I_WPA, I_WPB, I_WO, I_F2N, I_F2WI, I_F2WO, I_FINN };

__device__ __forceinline__ void transpose_item(const float* W, int ldw, int src_col0, const float* gain, bf16_t* WT, int K, int dst_row0, int k0, LAS float* scr, int lane) {
    const int c4 = lane & 7, rr = lane >> 3;
    f32x4 v[8]; float gv[8];
#pragma unroll
    for (int i = 0; i < 8; ++i) { const int kk = rr + 8 * i; v[i] = *(const f32x4*)(W + (size_t)(k0 + kk) * ldw + src_col0 + 4 * c4); gv[i] = gain ? gain[k0 + kk] : 1.0f; }
#pragma unroll
    for (int i = 0; i < 8; ++i) { const int kk = rr + 8 * i; LAS float* d = scr + kk * 33 + 4 * c4; d[0] = v[i][0] * gv[i]; d[1] = v[i][1] * gv[i]; d[2] = v[i][2] * gv[i]; d[3] = v[i][3] * gv[i]; }
    asm volatile("s_waitcnt lgkmcnt(0)" ::: "memory");
    const int c = lane & 7;
#pragma unroll
    for (int j = 0; j < 4; ++j) { const int n = (lane >> 3) + 8 * j; const LAS float* s = scr + (8 * c) * 33 + n;
        u32x4 o; o.x = pk2(s[0 * 33], s[1 * 33]); o.y = pk2(s[2 * 33], s[3 * 33]); o.z = pk2(s[4 * 33], s[5 * 33]); o.w = pk2(s[6 * 33], s[7 * 33]);
        *(u32x4*)(WT + (size_t)(dst_row0 + n) * K + k0 + 8 * c) = o; }
    asm volatile("s_waitcnt lgkmcnt(0)" ::: "memory");
}
__device__ __forceinline__ void transpose_matrix_item(int it, int kind, const float* W, int ldw, int K, int ndst, const float* gain, bf16_t* WT, LAS float* scr, int lane) {
    const int nblk = ndst / 32, kb = it / nblk, nb = it % nblk, n0 = 32 * nb; int src;
    if (kind == 1) { const int pn = nb >> 3, w = nb & 7; src = (w >> 2) * DFF + 128 * pn + 32 * (w & 3); }
    else if (kind == 2) src = n0 < 5120 ? n0 : n0 + 16;
    else src = n0;
    transpose_item(W, ldw, src, gain, WT, K, n0, 64 * kb, scr, lane);
}
__device__ __forceinline__ void p0_prep(const Params& p, LAS unsigned char* lds) {
    const int tid = threadIdx.x, lane = tid & 63, wave = tid >> 6;
    const int gw = blockIdx.x * 8 + wave, NGW = gridDim.x * 8;
    LAS float* scr = (LAS float*)(lds + wave * 16384);
    unsigned char* ws = p.ws;
    constexpr int I_FI = (D / 64) * (2 * DFF / 32), I_FO = (DFF / 64) * (D / 32), I_WI = (D / 64) * (7168 / 32), I_SQ = (D / 64) * (D / 32);
    constexpr int NITEMS = 2 * I_FI + 2 * I_FO + I_WI + 3 * I_SQ;
    for (int it = gw; it < NITEMS; it += NGW) {
        int r = it;
        if (r < I_FI) { transpose_matrix_item(r, 1, p.in[I_F1WI], 2 * DFF, D, 2 * DFF, p.in[I_F1N], (bf16_t*)(ws + WS_W1IN), scr, lane); continue; } r -= I_FI;
        if (r < I_FI) { transpose_matrix_item(r, 1, p.in[I_F2WI], 2 * DFF, D, 2 * DFF, p.in[I_F2N], (bf16_t*)(ws + WS_W2IN), scr, lane); continue; } r -= I_FI;
        if (r < I_FO) { transpose_matrix_item(r, 0, p.in[I_F1WO], D, DFF, D, nullptr, (bf16_t*)(ws + WS_W1OUT), scr, lane); continue; } r -= I_FO;
        if (r < I_FO) { transpose_matrix_item(r, 0, p.in[I_F2WO], D, DFF, D, nullptr, (bf16_t*)(ws + WS_W2OUT), scr, lane); continue; } r -= I_FO;
        if (r < I_WI) { transpose_matrix_item(r, 2, p.in[I_WIN], 7184, D, 7168, p.in[I_MIXN], (bf16_t*)(ws + WS_WIN), scr, lane); continue; } r -= I_WI;
        if (r < I_SQ) { transpose_matrix_item(r, 0, p.in[I_WPA], D, D, D, nullptr, (bf16_t*)(ws + WS_WPA), scr, lane); continue; } r -= I_SQ;
        if (r < I_SQ) { transpose_matrix_item(r, 0, p.in[I_WPB], D, D, D, p.in[I_BHN], (bf16_t*)(ws + WS_WPB), scr, lane); continue; } r -= I_SQ;
        transpose_matrix_item(r, 0, p.in[I_WO], D, D, D, nullptr, (bf16_t*)(ws + WS_WO), scr, lane);
    }
    {
        bf16_t* WT = (bf16_t*)(ws + WS_WIN) + (size_t)7168 * D; const float* W = p.in[I_WIN]; const float* wa = p.in[I_BWA]; const float* gn = p.in[I_MIXN];
        for (int idx = blockIdx.x * NTHREADS + tid; idx < 512 * D; idx += gridDim.x * NTHREADS) { const int n = idx >> 10, k = idx & 1023; float s = 0.f;
#pragma unroll
            for (int r = 0; r < 16; ++r) s += W[(size_t)k * 7184 + 5120 + r] * wa[r * 512 + n];
            WT[idx] = (bf16_t)f2bf(s * gn[k]); }
    }
    {
        const float* x = p.in[I_X]; bf16_t* xb = (bf16_t*)(ws + WS_XB); float* rs0 = (float*)(ws + WS_RS0);
        for (int m0 = gw * 4; m0 < T; m0 += NGW * 4) { f32x4 v[4][4];
#pragma unroll
            for (int q = 0; q < 4; ++q)
#pragma unroll
                for (int j = 0; j < 4; ++j) v[q][j] = *((const f32x4*)(x + (size_t)(m0 + q) * D) + lane + 64 * j);
#pragma unroll
            for (int q = 0; q < 4; ++q) { unsigned long long* o8 = (unsigned long long*)(xb + (size_t)(m0 + q) * D) + lane; float s = 0.f;
#pragma unroll
                for (int j = 0; j < 4; ++j) { const f32x4 t = v[q][j]; s += (t[0] * t[0] + t[1] * t[1]) + (t[2] * t[2] + t[3] * t[3]); o8[64 * j] = (unsigned long long)cvt2(t[0], t[1]) | ((unsigned long long)cvt2(t[2], t[3]) << 32); }
                s = wave_sum(s); if (lane == 0) rs0[m0 + q] = __builtin_amdgcn_rsqf(s * (1.0f / D) + EPS); } }
    }
}

#define LDS_BARRIER() do { asm volatile("s_waitcnt lgkmcnt(0)" ::: "memory"); __builtin_amdgcn_s_barrier(); asm volatile("" ::: "memory"); } while (0)

namespace gla2 {
constexpr int QP = 272, QOP = 264, JP = 144;
constexpr int OFF_QI = 0, OFF_KI = OFF_QI + 64 * QP, OFF_QO = OFF_KI + 64 * QP, OFF_KST = OFF_QO + 64 * QOP, OFF_VT = OFF_KST + 128 * JP, OFF_PL = OFF_VT + 256 * JP,
              OFF_TOT = OFF_PL + 64 * JP, OFF_DEC = OFF_TOT + 4096, OFF_RED = OFF_DEC + 512, OFF_HG = OFF_RED + 2048, END = OFF_HG + 1024;
static_assert(END <= 131072 && OFF_QO % 16 == 0 && OFF_KST % 16 == 0 && OFF_VT % 16 == 0 && OFF_PL % 16 == 0 && OFF_TOT % 16 == 0 && OFF_HG % 16 == 0, "gla2 lds map");
constexpr int NSEG = 8, LSEG = (SEQ / 64) / NSEG, NITEMS = 32 * NSEG;
}
template <bool FULL>
__device__ __forceinline__ void gla_run(const Params& p, LAS unsigned char* lds, int b, int h, int n_begin, int n_end, f32x16 (&X)[4], float& dprod) {
    using namespace gla2;
    const int tid = threadIdx.x, lane = tid & 63, wave = __builtin_amdgcn_readfirstlane(tid >> 6), r = lane & 31, hh = lane >> 5;
    unsigned char* ws = p.ws;
    const bf16_t* Q = (const bf16_t*)(ws + WS_Q); const bf16_t* Kb = (const bf16_t*)(ws + WS_K); const bf16_t* VB = (const bf16_t*)(ws + WS_VB); const bf16_t* LA = (const bf16_t*)(ws + WS_LA);
    bf16_t* R = (bf16_t*)(ws + WS_R);
    constexpr bool full = FULL;
    const int kp = lane, jg = wave;
    const int vp = tid & 127, jq = tid >> 7;
    LDS_BARRIER();
    if (wave >= 4) __builtin_amdgcn_s_setprio(1);
    unsigned qw[8], kw[8], lw[8], vw[16];
    const size_t rowb = (size_t)b * SEQ;
#define GLA_LOAD_QKL(n) do { \
        _Pragma("unroll") for (int jj = 0; jj < 8; ++jj) { const size_t row = rowb + 64 * (n) + 8 * jg + jj; \
            qw[jj] = *(const unsigned*)(Q + row * 512 + h * 128 + 2 * kp); kw[jj] = *(const unsigned*)(Kb + row * 512 + h * 128 + 2 * kp); lw[jj] = *(const unsigned*)(LA + row * 512 + h * 128 + 2 * kp); } } while (0)
#define GLA_LOAD_V(n) do { \
        _Pragma("unroll") for (int jj = 0; jj < 16; ++jj) { const size_t row = rowb + 64 * (n) + 16 * jq + jj; vw[jj] = *(const unsigned*)(VB + row * 1024 + h * 256 + 2 * vp); } } while (0)
    GLA_LOAD_QKL(n_begin); GLA_LOAD_V(n_begin);
    for (int n = n_begin; n < n_end; ++n) {
        f32x2 pre = {0.f, 0.f}, mid = {0.f, 0.f}, last = {0.f, 0.f};
        {
            float run0 = 0.f, run1 = 0.f;
#pragma unroll
            for (int jj = 0; jj < 8; ++jj) { run0 += bflo(lw[jj]); run1 += bfhi(lw[jj]); }
            *(LAS f32x2*)(lds + OFF_TOT + (jg * 128 + 2 * kp) * 4) = (f32x2){run0, run1};
            u32x4 lo0, lo1, hi0, hi1;
#pragma unroll
            for (int m = 0; m < 4; ++m) { lo0[m] = (vw[2 * m] & 0xffffu) | (vw[2 * m + 1] << 16); hi0[m] = (vw[2 * m] >> 16) | (vw[2 * m + 1] & 0xffff0000u);
                                          lo1[m] = (vw[8 + 2 * m] & 0xffffu) | (vw[8 + 2 * m + 1] << 16); hi1[m] = (vw[8 + 2 * m] >> 16) | (vw[8 + 2 * m + 1] & 0xffff0000u); }
            LAS unsigned char* v0 = lds + OFF_VT + (2 * vp) * JP + 2 * (16 * jq); LAS unsigned char* v1 = v0 + JP;
            *(LAS u32x4*)v0 = lo0; *(LAS u32x4*)(v0 + 16) = lo1; *(LAS u32x4*)v1 = hi0; *(LAS u32x4*)(v1 + 16) = hi1;
        }
        LDS_BARRIER();
        {
#pragma unroll
            for (int g = 0; g < 8; ++g) { const f32x2 t = *(const LAS f32x2*)(lds + OFF_TOT + (g * 128 + 2 * kp) * 4); if (g < jg) pre += t; if (g < 4) mid += t; last += t; }
            const float EM0 = __builtin_amdgcn_exp2f(mid.x), EM1 = __builtin_amdgcn_exp2f(mid.y), EL0 = __builtin_amdgcn_exp2f(last.x - mid.x), EL1 = __builtin_amdgcn_exp2f(last.y - mid.y);
            if (jg == 0) *(LAS f32x2*)(lds + OFF_DEC + 2 * kp * 4) = (f32x2){__builtin_amdgcn_exp2f(last.x), __builtin_amdgcn_exp2f(last.y)};
            f32x8 ks0, ks1; float run0 = pre.x - mid.x, run1 = pre.y - mid.y;
#pragma unroll
            for (int jj = 0; jj < 8; ++jj) {
                run0 += bflo(lw[jj]); run1 += bfhi(lw[jj]);
                const float e0 = __builtin_amdgcn_exp2f(run0), e1 = __builtin_amdgcn_exp2f(run1), r0 = __builtin_amdgcn_rcpf(e0), r1 = __builtin_amdgcn_rcpf(e1);
                const float ki0 = bflo(kw[jj]) * r0, ki1 = bfhi(kw[jj]) * r1;
                ks0[jj] = ki0 * EL0; ks1[jj] = ki1 * EL1;
                if (full) { const float qi0 = bflo(qw[jj]) * e0, qi1 = bfhi(qw[jj]) * e1; const int row = 8 * jg + jj;
                    *(LAS unsigned*)(lds + OFF_QI + row * QP + 4 * kp) = cvt2(qi0, qi1);
                    *(LAS unsigned*)(lds + OFF_KI + row * QP + 4 * kp) = cvt2(ki0, ki1);
                    *(LAS unsigned*)(lds + OFF_QO + row * QOP + 4 * kp) = cvt2(qi0 * EM0, qi1 * EM1); }
            }
            *(LAS bf16x8*)(lds + OFF_KST + (2 * kp) * JP + 16 * jg) = cvt8(ks0);
            *(LAS bf16x8*)(lds + OFF_KST + (2 * kp + 1) * JP + 16 * jg) = cvt8(ks1);
        }
        const int nn = (n + 1 < n_end) ? n + 1 : n;
        GLA_LOAD_QKL(nn);
        bf16_t* const rp0 = R + (rowb + 64 * n + r) * 1024 + h * 256 + 32 * wave + 4 * hh;
        LDS_BARRIER();
        if (full) {
#pragma unroll
            for (int tt = 0; tt < 2; ++tt) { const int t = 2 * wave + tt, jt = t >> 2, it = t & 3; f32x4 acc = {0.f, 0.f, 0.f, 0.f};
                if (jt <= it) {
                    bf16x8 A[4], B[4];
#pragma unroll
                    for (int ks = 0; ks < 4; ++ks) { A[ks] = *(const LAS bf16x8*)(lds + OFF_KI + (16 * jt + (lane & 15)) * QP + 2 * (32 * ks + 8 * (lane >> 4)));
                                                     B[ks] = *(const LAS bf16x8*)(lds + OFF_QI + (16 * it + (lane & 15)) * QP + 2 * (32 * ks + 8 * (lane >> 4))); }
#pragma unroll
                    for (int ks = 0; ks < 4; ++ks) acc = __builtin_amdgcn_mfma_f32_16x16x32_bf16(A[ks], B[ks], acc, 0, 0, 0);
                }
                const int i = 16 * it + (lane & 15), j0 = 16 * jt + 4 * (lane >> 4);
                u32x2 o; o.x = cvt2(j0 <= i ? acc[0] : 0.f, j0 + 1 <= i ? acc[1] : 0.f); o.y = cvt2(j0 + 2 <= i ? acc[2] : 0.f, j0 + 3 <= i ? acc[3] : 0.f);
                *(LAS u32x2*)(lds + OFF_PL + i * JP + 2 * j0) = o; }
            LDS_BARRIER();
        }
        if (!FULL && tid < 128) dprod *= *(const LAS float*)(lds + OFF_DEC + tid * 4);
        const LAS unsigned char* vrow = lds + OFF_VT + (32 * wave + r) * JP + 16 * hh;
        bf16x8 vf[4];
#pragma unroll
        for (int ks = 0; ks < 4; ++ks) vf[ks] = *(const LAS bf16x8*)(vrow + 32 * ks);
        f32x16 oT[2];
        if (full) {
#pragma unroll
            for (int it2 = 0; it2 < 2; ++it2)
#pragma unroll
                for (int e = 0; e < 16; ++e) oT[it2][e] = 0.f;
            {
                bf16x8 p0[2], p1[4];
#pragma unroll
                for (int ks = 0; ks < 2; ++ks) p0[ks] = *(const LAS bf16x8*)(lds + OFF_PL + r * JP + 32 * ks + 16 * hh);
#pragma unroll
                for (int ks = 0; ks < 4; ++ks) p1[ks] = *(const LAS bf16x8*)(lds + OFF_PL + (32 + r) * JP + 32 * ks + 16 * hh);
                oT[0] = __builtin_amdgcn_mfma_f32_32x32x16_bf16(vf[0], p0[0], oT[0], 0, 0, 0); oT[1] = __builtin_amdgcn_mfma_f32_32x32x16_bf16(vf[0], p1[0], oT[1], 0, 0, 0);
                oT[0] = __builtin_amdgcn_mfma_f32_32x32x16_bf16(vf[1], p0[1], oT[0], 0, 0, 0); oT[1] = __builtin_amdgcn_mfma_f32_32x32x16_bf16(vf[1], p1[1], oT[1], 0, 0, 0);
                oT[1] = __builtin_amdgcn_mfma_f32_32x32x16_bf16(vf[2], p1[2], oT[1], 0, 0, 0); oT[1] = __builtin_amdgcn_mfma_f32_32x32x16_bf16(vf[3], p1[3], oT[1], 0, 0, 0);
            }
            __builtin_amdgcn_sched_barrier(0);
#pragma unroll
            for (int kh = 0; kh < 2; ++kh) {
                u32x4 bq[2][2][2];
#pragma unroll
                for (int k2 = 0; k2 < 2; ++k2)
#pragma unroll
                    for (int s = 0; s < 2; ++s)
#pragma unroll
                        for (int it2 = 0; it2 < 2; ++it2) { const LAS unsigned char* qp = lds + OFF_QO + (32 * it2 + r) * QOP + 2 * (32 * (2 * kh + k2) + 16 * s + 4 * hh);
                            const u32x2 b0 = *(const LAS u32x2*)qp, b1 = *(const LAS u32x2*)(qp + 16); bq[k2][s][it2] = (u32x4){b0.x, b0.y, b1.x, b1.y}; }
#pragma unroll
                for (int k2 = 0; k2 < 2; ++k2)
#pragma unroll
                    for (int s = 0; s < 2; ++s) { f32x8 xs;
#pragma unroll
                        for (int e = 0; e < 8; ++e) xs[e] = X[2 * kh + k2][8 * s + e];
                        const bf16x8 A = cvt8(xs);
                        oT[0] = __builtin_amdgcn_mfma_f32_32x32x16_bf16(A, __builtin_bit_cast(bf16x8, bq[k2][s][0]), oT[0], 0, 0, 0);
                        oT[1] = __builtin_amdgcn_mfma_f32_32x32x16_bf16(A, __builtin_bit_cast(bf16x8, bq[k2][s][1]), oT[1], 0, 0, 0); }
                __builtin_amdgcn_sched_barrier(0);
            }
        }
        __builtin_amdgcn_sched_barrier(0);
        GLA_LOAD_V(nn);
        __builtin_amdgcn_sched_barrier(0);
#pragma unroll
        for (int kh = 0; kh < 2; ++kh) {
            bf16x8 ka[2][4];
#pragma unroll
            for (int k2 = 0; k2 < 2; ++k2)
#pragma unroll
                for (int ks = 0; ks < 4; ++ks) ka[k2][ks] = *(const LAS bf16x8*)(lds + OFF_KST + (32 * (2 * kh + k2) + r) * JP + 32 * ks + 16 * hh);
#pragma unroll
            for (int k2 = 0; k2 < 2; ++k2)
#pragma unroll
                for (int g4 = 0; g4 < 4; ++g4) { const f32x4 dv = *(const LAS f32x4*)(lds + OFF_DEC + (32 * (2 * kh + k2) + 8 * g4 + 4 * hh) * 4);
#pragma unroll
                    for (int e = 0; e < 4; ++e) X[2 * kh + k2][4 * g4 + e] *= dv[e]; }
#pragma unroll
            for (int ks = 0; ks < 4; ++ks)
#pragma unroll
                for (int k2 = 0; k2 < 2; ++k2) X[2 * kh + k2] = __builtin_amdgcn_mfma_f32_32x32x16_bf16(ka[k2][ks], vf[ks], X[2 * kh + k2], 0, 0, 0);
            __builtin_amdgcn_sched_barrier(0);
        }
        if (full) {
            bf16_t* const rq0 = R + (rowb + 64 * n + (lane >> 2)) * 1024 + h * 256 + 32 * wave + 8 * (lane & 3);
            u32x4 rq[4];
#pragma unroll
            for (int k = 0; k < 4; ++k) rq[k] = *(const u32x4*)(rq0 + (size_t)k * 16 * 1024);
#pragma unroll
            for (int it2 = 0; it2 < 2; ++it2) { float ss = 0.f;
#pragma unroll
                for (int e = 0; e < 16; ++e) ss += oT[it2][e] * oT[it2][e];
                ss += __shfl_xor(ss, 32);
                if (hh == 0) *(LAS float*)(lds + OFF_RED + ((32 * it2 + r) * 8 + wave) * 4) = ss; }
            LDS_BARRIER();
            LAS unsigned char* stg = lds + OFF_VT + (32 * wave) * JP;
#pragma unroll
            for (int it2 = 0; it2 < 2; ++it2) { const f32x4 s0 = *(const LAS f32x4*)(lds + OFF_RED + (32 * it2 + r) * 32), s1 = *(const LAS f32x4*)(lds + OFF_RED + (32 * it2 + r) * 32 + 16);
                const float rs = __builtin_amdgcn_rsqf(((s0[0] + s0[1]) + (s0[2] + s0[3]) + (s1[0] + s1[1]) + (s1[2] + s1[3])) * (1.0f / 256.0f) + EPS);
#pragma unroll
                for (int g4 = 0; g4 < 4; ++g4) { u32x2 o; o.x = cvt2(oT[it2][4 * g4 + 0] * rs, oT[it2][4 * g4 + 1] * rs); o.y = cvt2(oT[it2][4 * g4 + 2] * rs, oT[it2][4 * g4 + 3] * rs);
                    *(LAS u32x2*)(stg + (32 * it2 + r) * 72 + 2 * (8 * g4 + 4 * hh)) = o; } }
            asm volatile("s_waitcnt lgkmcnt(0)" ::: "memory");
#pragma unroll
            for (int k = 0; k < 4; ++k) { const LAS unsigned char* sp = stg + ((lane >> 2) + 16 * k) * 72 + 16 * (lane & 3);
                const u32x2 a = *(const LAS u32x2*)sp, b = *(const LAS u32x2*)(sp + 8); const u32x4 rv = rq[k]; u32x4 o;
                o.x = cvt2(bflo(a.x) * bflo(rv.x), bfhi(a.x) * bfhi(rv.x)); o.y = cvt2(bflo(a.y) * bflo(rv.y), bfhi(a.y) * bfhi(rv.y));
                o.z = cvt2(bflo(b.x) * bflo(rv.z), bfhi(b.x) * bfhi(rv.z)); o.w = cvt2(bflo(b.y) * bflo(rv.w), bfhi(b.y) * bfhi(rv.w));
                *(u32x4*)(rq0 + (size_t)k * 16 * 1024) = o; }
        }
        LDS_BARRIER();
    }
    __builtin_amdgcn_s_setprio(0);
#undef GLA_LOAD_QKL
#undef GLA_LOAD_V
}

namespace gm2 {
constexpr int WP = 272;
constexpr int OFF_WS = 0, OFF_VT = 128 * WP, OFF_MU = 2 * 128 * WP, OFF_RS = OFF_MU + 512, OFF_NXT = OFF_RS + 512;
}
__device__ __forceinline__ void p4_gmlp2(const Params& p, LAS unsigned char* lds, unsigned* ctr) {
    using namespace gm2;
    const int tid = threadIdx.x, lane = tid & 63, wave = __builtin_amdgcn_readfirstlane(tid >> 6), r = lane & 31, hh = lane >> 5;
    unsigned char* ws = p.ws;
    bf16_t* U = (bf16_t*)(ws + WS_U); const bf16_t* V = (const bf16_t*)(ws + WS_V); const float* lnst = (const float*)(ws + WS_LNST);
    const float* lg = p.in[I_ALNG]; const float* lb = p.in[I_ALNB]; const float* Wsg = p.in[I_AWS]; const float* bs = p.in[I_ABS];
    LAS float* mu = (LAS float*)(lds + OFF_MU); LAS float* rstd = (LAS float*)(lds + OFF_RS); LAS int* nxt = (LAS int*)(lds + OFF_NXT);
    const int it = wave >> 1, ct0 = 2 * (wave & 1), cp = lane, jg = wave, tok = tid >> 2, sub = tid & 3;
    for (int gi = 0; gi < 8; ++gi) {
        const int g = (blockIdx.x + gi) & 7;
        LDS_BARRIER();
        if (tid == 0) { const int c0 = (int)atomicAdd(ctr + g, 1u); const int c1 = (int)atomicAdd(ctr + g, 1u); nxt[0] = c0; nxt[1] = c1; }
        LDS_BARRIER();
        int chunk = nxt[0], next = nxt[1];
        if (chunk >= 512) continue;
        for (int e = tid; e < 128 * 64; e += NTHREADS) { const int i = e >> 6, j = 2 * (e & 63); const f32x2 w = *(const f32x2*)(Wsg + (size_t)g * 16384 + i * 128 + j);
            *(LAS unsigned*)(lds + OFF_WS + i * WP + 2 * j) = cvt2(j <= i ? w.x : 0.f, j + 1 <= i ? w.y : 0.f); }
        const f32x2 lgv = *(const f32x2*)(lg + g * 128 + 2 * cp), lbv = *(const f32x2*)(lb + g * 128 + 2 * cp);
        unsigned vw[16]; f32x4 st0, st1;
#define GM_LOAD_RAW(ch) do { const size_t t0_ = (size_t)(ch) * 128; \
            _Pragma("unroll") for (int jj = 0; jj < 16; ++jj) vw[jj] = *(const unsigned*)(V + (t0_ + 16 * jg + jj) * 1024 + g * 128 + 2 * cp); \
            st0 = *(const f32x4*)(lnst + (t0_ + tok) * 32 + sub * 8); st1 = *(const f32x4*)(lnst + (t0_ + tok) * 32 + sub * 8 + 4); } while (0)
        GM_LOAD_RAW(chunk);
        while (chunk < 512) {
            const size_t t0 = (size_t)chunk * 128;
            int next2 = 0; if (tid == 0) next2 = (int)atomicAdd(ctr + g, 1u);
            const int i = 32 * it + r;
            u32x2 uw[2][4];
#pragma unroll
            for (int cc = 0; cc < 2; ++cc)
#pragma unroll
                for (int g4 = 0; g4 < 4; ++g4) uw[cc][g4] = *(const u32x2*)(U + (t0 + i) * 1024 + g * 128 + 32 * (ct0 + cc) + 8 * g4 + 4 * hh);
            const float bsv = bs[g * 128 + i];
            {
                float s1 = (st0[0] + st0[2]) + (st1[0] + st1[2]), s2 = (st0[1] + st0[3]) + (st1[1] + st1[3]);
                s1 += __shfl_xor(s1, 1); s2 += __shfl_xor(s2, 1); s1 += __shfl_xor(s1, 2); s2 += __shfl_xor(s2, 2);
                const float mean = s1 * (1.0f / 1024.0f), var = s2 * (1.0f / 1024.0f) - mean * mean;
                LDS_BARRIER();
                if (sub == 0) { mu[tok] = mean; rstd[tok] = 1.0f / sqrtf(fmaxf(var, 0.f) + EPS); }
            }
            LDS_BARRIER();
            {
                f32x8 a0[2], a1[2];
#pragma unroll
                for (int jj = 0; jj < 16; ++jj) { const float m = mu[16 * jg + jj], rs = rstd[16 * jg + jj];
                    a0[jj >> 3][jj & 7] = (bflo(vw[jj]) - m) * rs * lgv.x + lbv.x; a1[jj >> 3][jj & 7] = (bfhi(vw[jj]) - m) * rs * lgv.y + lbv.y; }
#pragma unroll
                for (int q = 0; q < 2; ++q) { *(LAS bf16x8*)(lds + OFF_VT + (2 * cp) * WP + 2 * (16 * jg + 8 * q)) = cvt8(a0[q]); *(LAS bf16x8*)(lds + OFF_VT + (2 * cp + 1) * WP + 2 * (16 * jg + 8 * q)) = cvt8(a1[q]); }
            }
            { const int nn = next < 512 ? next : 511; GM_LOAD_RAW(nn); }
            LDS_BARRIER();
            f32x16 acc[2];
#pragma unroll
            for (int cc = 0; cc < 2; ++cc)
#pragma unroll
                for (int e = 0; e < 16; ++e) acc[cc][e] = 0.f;
            const int nks = 2 * it + 2;
            for (int ks = 0; ks < nks; ks += 2) {
                bf16x8 B[2], A[2][2];
#pragma unroll
                for (int k2 = 0; k2 < 2; ++k2) { B[k2] = *(const LAS bf16x8*)(lds + OFF_WS + (32 * it + r) * WP + 2 * (16 * (ks + k2) + 8 * hh));
#pragma unroll
                    for (int cc = 0; cc < 2; ++cc) A[k2][cc] = *(const LAS bf16x8*)(lds + OFF_VT + (32 * (ct0 + cc) + r) * WP + 2 * (16 * (ks + k2) + 8 * hh)); }
#pragma unroll
                for (int k2 = 0; k2 < 2; ++k2)
#pragma unroll
                    for (int cc = 0; cc < 2; ++cc) acc[cc] = __builtin_amdgcn_mfma_f32_32x32x16_bf16(A[k2][cc], B[k2], acc[cc], 0, 0, 0);
            }
#pragma unroll
            for (int cc = 0; cc < 2; ++cc)
#pragma unroll
                for (int g4 = 0; g4 < 4; ++g4) { const u32x2 w = uw[cc][g4]; u32x2 o;
                    o.x = cvt2(bflo(w.x) * (acc[cc][4 * g4 + 0] + bsv), bfhi(w.x) * (acc[cc][4 * g4 + 1] + bsv)); o.y = cvt2(bflo(w.y) * (acc[cc][4 * g4 + 2] + bsv), bfhi(w.y) * (acc[cc][4 * g4 + 3] + bsv));
                    *(u32x2*)(U + (t0 + i) * 1024 + g * 128 + 32 * (ct0 + cc) + 8 * g4 + 4 * hh) = o; }
            if (tid == 0) nxt[2] = next2;
            LDS_BARRIER();
            chunk = next; next = nxt[2];
        }
#undef GM_LOAD_RAW
    }
    LDS_BARRIER();
}


namespace gm3 {
constexpr int WP = 272;
constexpr int OFF_WS = 0, OFF_VT0 = 128 * WP, OFF_VT1 = 2 * 128 * WP, OFF_MU = 3 * 128 * WP, OFF_SLOT = OFF_MU + 1024, OFF_OUT = OFF_SLOT + 512;
}
__device__ __forceinline__ void p4_gmlp3(const Params& p, LAS unsigned char* lds, unsigned* ctr) {
    using namespace gm3;
    const int tid = threadIdx.x, lane = tid & 63, wave = __builtin_amdgcn_readfirstlane(tid >> 6), r = lane & 31, hh = lane >> 5;
    unsigned char* ws = p.ws;
    bf16_t* U = (bf16_t*)(ws + WS_U); const bf16_t* V = (const bf16_t*)(ws + WS_V); const float* lnst = (const float*)(ws + WS_LNST);
    const float* lg = p.in[I_ALNG]; const float* lb = p.in[I_ALNB]; const float* Wsg = p.in[I_AWS]; const float* bs = p.in[I_ABS];
    LAS float* muw = (LAS float*)(lds + OFF_MU) + wave * 32;
    LAS int* slot = (LAS int*)(lds + OFF_SLOT);
    const int ct = wave & 3, ita = (wave < 4) ? 0 : 1, itb = 3 - ita;
    const int cp = lane, jg = wave, tsub = lane >> 2, sub = lane & 3;
    if (wave >= 4) __builtin_amdgcn_s_setprio(1);
    for (int gi = 0; gi < 8; ++gi) {
        const int g = (blockIdx.x + gi) & 7;
        LDS_BARRIER();
        if (tid == 0) { slot[0] = (int)atomicAdd(ctr + g, 1u); slot[1] = (int)atomicAdd(ctr + g, 1u); slot[2] = (int)atomicAdd(ctr + g, 1u); }
        LDS_BARRIER();
        int cur = slot[0], nxc = slot[1], nn2 = slot[2];
        if (cur >= 512) continue;
        for (int e = tid; e < 128 * 64; e += NTHREADS) { const int i = e >> 6, j = 2 * (e & 63); const f32x2 w = *(const f32x2*)(Wsg + (size_t)g * 16384 + i * 128 + j);
            *(LAS unsigned*)(lds + OFF_WS + i * WP + 2 * j) = cvt2(j <= i ? w.x : 0.f, j + 1 <= i ? w.y : 0.f); }
        const f32x2 lgv = *(const f32x2*)(lg + g * 128 + 2 * cp), lbv = *(const f32x2*)(lb + g * 128 + 2 * cp);
        const float bsa = bs[g * 128 + 32 * ita + r], bsb = bs[g * 128 + 32 * itb + r];
        unsigned vw[16]; f32x4 st0, st1;
#define GM_LOAD_RAW(ch) do { const size_t t0_ = (size_t)(ch) * 128; \
            _Pragma("unroll") for (int jj = 0; jj < 16; ++jj) vw[jj] = *(const unsigned*)(V + (t0_ + 16 * jg + jj) * 1024 + g * 128 + 2 * cp); \
            st0 = *(const f32x4*)(lnst + (t0_ + 16 * jg + tsub) * 32 + sub * 8); st1 = *(const f32x4*)(lnst + (t0_ + 16 * jg + tsub) * 32 + sub * 8 + 4); } while (0)
#define GM_LN(vt) do { \
            float s1_ = (st0[0] + st0[2]) + (st1[0] + st1[2]), s2_ = (st0[1] + st0[3]) + (st1[1] + st1[3]); \
            s1_ += __shfl_xor(s1_, 1); s2_ += __shfl_xor(s2_, 1); s1_ += __shfl_xor(s1_, 2); s2_ += __shfl_xor(s2_, 2); \
            const float mean_ = s1_ * (1.0f / 1024.0f), var_ = s2_ * (1.0f / 1024.0f) - mean_ * mean_; \
            if (sub == 0) *(LAS f32x2*)(muw + 2 * tsub) = (f32x2){mean_, __builtin_amdgcn_rsqf(fmaxf(var_, 0.f) + EPS)}; \
            asm volatile("s_waitcnt lgkmcnt(0)" ::: "memory"); \
            f32x8 a0_[2], a1_[2]; \
            _Pragma("unroll") for (int q_ = 0; q_ < 8; ++q_) { const f32x4 mr_ = *(const LAS f32x4*)(muw + 4 * q_); \
                a0_[q_ >> 2][(2 * q_) & 7] = (bflo(vw[2 * q_]) - mr_[0]) * mr_[1] * lgv.x + lbv.x; a1_[q_ >> 2][(2 * q_) & 7] = (bfhi(vw[2 * q_]) - mr_[0]) * mr_[1] * lgv.y + lbv.y; \
                a0_[q_ >> 2][(2 * q_ + 1) & 7] = (bflo(vw[2 * q_ + 1]) - mr_[2]) * mr_[3] * lgv.x + lbv.x; a1_[q_ >> 2][(2 * q_ + 1) & 7] = (bfhi(vw[2 * q_ + 1]) - mr_[2]) * mr_[3] * lgv.y + lbv.y; } \
            _Pragma("unroll") for (int q_ = 0; q_ < 2; ++q_) { *(LAS bf16x8*)((vt) + (2 * cp) * WP + 2 * (16 * jg + 8 * q_)) = cvt8(a0_[q_]); *(LAS bf16x8*)((vt) + (2 * cp + 1) * WP + 2 * (16 * jg + 8 * q_)) = cvt8(a1_[q_]); } \
            asm volatile("s_waitcnt lgkmcnt(0)" ::: "memory"); } while (0)
        GM_LOAD_RAW(cur);
        GM_LN(lds + OFF_VT0);
        { const int c1 = nxc < 512 ? nxc : 511; GM_LOAD_RAW(c1); }
        int tk = 0; if (tid == 0) tk = (int)atomicAdd(ctr + g, 1u);
        int buf = 0;
        while (cur < 512) {
            const size_t t0 = (size_t)cur * 128;
            const int nn = nn2;
            if (tid == 0) slot[buf] = tk;
            LDS_BARRIER();
            nn2 = slot[buf];
            if (tid == 0) tk = (int)atomicAdd(ctr + g, 1u);
            LAS unsigned char* vt = lds + (buf ? OFF_VT1 : OFF_VT0);
            u32x4 uq[4];
#pragma unroll
            for (int k = 0; k < 4; ++k) uq[k] = *(const u32x4*)(U + (t0 + (tid >> 4) + 32 * k) * 1024 + g * 128 + 8 * (tid & 15));
            f32x16 acca, accb;
#pragma unroll
            for (int e = 0; e < 16; ++e) { acca[e] = 0.f; accb[e] = 0.f; }
            for (int ks = 0; ks < 2 * ita + 2; ++ks) { const bf16x8 A = *(const LAS bf16x8*)(vt + (32 * ct + r) * WP + 2 * (16 * ks + 8 * hh));
                const bf16x8 Ba = *(const LAS bf16x8*)(lds + OFF_WS + (32 * ita + r) * WP + 2 * (16 * ks + 8 * hh)), Bb = *(const LAS bf16x8*)(lds + OFF_WS + (32 * itb + r) * WP + 2 * (16 * ks + 8 * hh));
                acca = __builtin_amdgcn_mfma_f32_32x32x16_bf16(A, Ba, acca, 0, 0, 0); accb = __builtin_amdgcn_mfma_f32_32x32x16_bf16(A, Bb, accb, 0, 0, 0); }
            for (int ks = 2 * ita + 2; ks < 2 * itb + 2; ++ks) { const bf16x8 A = *(const LAS bf16x8*)(vt + (32 * ct + r) * WP + 2 * (16 * ks + 8 * hh));
                const bf16x8 Bb = *(const LAS bf16x8*)(lds + OFF_WS + (32 * itb + r) * WP + 2 * (16 * ks + 8 * hh));
                accb = __builtin_amdgcn_mfma_f32_32x32x16_bf16(A, Bb, accb, 0, 0, 0); }
            if (nxc < 512) GM_LN(lds + (buf ? OFF_VT0 : OFF_VT1));
            { const int c2 = nn < 512 ? nn : 511; GM_LOAD_RAW(c2); }
#pragma unroll
            for (int g4 = 0; g4 < 4; ++g4) {
                u32x2 o; o.x = cvt2(acca[4 * g4 + 0] + bsa, acca[4 * g4 + 1] + bsa); o.y = cvt2(acca[4 * g4 + 2] + bsa, acca[4 * g4 + 3] + bsa);
                *(LAS u32x2*)(lds + OFF_OUT + (32 * ita + r) * WP + 2 * (32 * ct + 8 * g4 + 4 * hh)) = o;
                o.x = cvt2(accb[4 * g4 + 0] + bsb, accb[4 * g4 + 1] + bsb); o.y = cvt2(accb[4 * g4 + 2] + bsb, accb[4 * g4 + 3] + bsb);
                *(LAS u32x2*)(lds + OFF_OUT + (32 * itb + r) * WP + 2 * (32 * ct + 8 * g4 + 4 * hh)) = o; }
            LDS_BARRIER();
#pragma unroll
            for (int k = 0; k < 4; ++k) { const u32x4 sp = *(const LAS u32x4*)(lds + OFF_OUT + ((tid >> 4) + 32 * k) * WP + 16 * (tid & 15)); const u32x4 uu = uq[k]; u32x4 o;
                o.x = cvt2(bflo(uu.x) * bflo(sp.x), bfhi(uu.x) * bfhi(sp.x)); o.y = cvt2(bflo(uu.y) * bflo(sp.y), bfhi(uu.y) * bfhi(sp.y));
                o.z = cvt2(bflo(uu.z) * bflo(sp.z), bfhi(uu.z) * bfhi(sp.z)); o.w = cvt2(bflo(uu.w) * bflo(sp.w), bfhi(uu.w) * bfhi(sp.w));
                *(u32x4*)(U + (t0 + (tid >> 4) + 32 * k) * 1024 + g * 128 + 8 * (tid & 15)) = o; }
            cur = nxc; nxc = nn; buf ^= 1;
        }
#undef GM_LOAD_RAW
#undef GM_LN
    }
    __builtin_amdgcn_s_setprio(0);
    LDS_BARRIER();
}

__device__ __forceinline__ void p4_gla_pass1(const Params& p, LAS unsigned char* lds) {
    using namespace gla2;
    const int tid = threadIdx.x, lane = tid & 63, wave = __builtin_amdgcn_readfirstlane(tid >> 6);
    float* E = (float*)(p.ws + WS_GLAE); float* Dg = (float*)(p.ws + WS_GLAD);
    for (int item = blockIdx.x; item < NITEMS; item += gridDim.x) {
        const int bh = item / NSEG, seg = item - bh * NSEG; if (seg == NSEG - 1) continue;
        f32x16 X[4];
#pragma unroll
        for (int kt = 0; kt < 4; ++kt)
#pragma unroll
            for (int e = 0; e < 16; ++e) X[kt][e] = 0.f;
        float dprod = 1.f;
        gla_run<false>(p, lds, bh >> 2, bh & 3, seg * LSEG, (seg + 1) * LSEG, X, dprod);
#pragma unroll
        for (int kt = 0; kt < 4; ++kt)
#pragma unroll
            for (int e = 0; e < 16; ++e) E[((((size_t)item * 8 + wave) * 4 + kt) * 16 + e) * 64 + lane] = X[kt][e];
        if (tid < 128) Dg[item * 128 + tid] = dprod;
    }
}
__device__ __forceinline__ void p4_gla_pass2(const Params& p, LAS unsigned char* lds) {
    using namespace gla2;
    const int tid = threadIdx.x, lane = tid & 63, wave = __builtin_amdgcn_readfirstlane(tid >> 6), hh = lane >> 5;
    const float* E = (const float*)(p.ws + WS_GLAE); const float* Dg = (const float*)(p.ws + WS_GLAD);
    for (int item = blockIdx.x; item < NITEMS; item += gridDim.x) {
        const int bh = item / NSEG, seg = item - bh * NSEG;
        f32x16 X[4];
#pragma unroll
        for (int kt = 0; kt < 4; ++kt)
#pragma unroll
            for (int e = 0; e < 16; ++e) X[kt][e] = 0.f;
        for (int sp = 0; sp < seg; ++sp) { const int it = bh * NSEG + sp;
#pragma unroll
            for (int kt = 0; kt < 4; ++kt)
#pragma unroll
                for (int g4 = 0; g4 < 4; ++g4) { const f32x4 dv = *(const f32x4*)(Dg + it * 128 + 32 * kt + 8 * g4 + 4 * hh);
#pragma unroll
                    for (int e = 0; e < 4; ++e) X[kt][4 * g4 + e] = X[kt][4 * g4 + e] * dv[e] + E[((((size_t)it * 8 + wave) * 4 + kt) * 16 + 4 * g4 + e) * 64 + lane]; } }
        float dummy = 1.f;
        gla_run<true>(p, lds, bh >> 2, bh & 3, seg * LSEG, (seg + 1) * LSEG, X, dummy);
    }
}

__device__ __forceinline__ void p9_final(const Params& p) {
    const int tid = threadIdx.x, lane = tid & 63, wave = tid >> 6;
    const int gw = blockIdx.x * 8 + wave, NGW = gridDim.x * 8;
    const bf16_t* X3 = (const bf16_t*)(p.ws + WS_X2B);
    f32x4 gv[4];
#pragma unroll
    for (int k = 0; k < 4; ++k) gv[k] = *((const f32x4*)(p.in[I_FINN]) + lane + 64 * k);
    for (int m0 = gw * 4; m0 < T; m0 += NGW * 4) {
        u32x2 w[4][4];
#pragma unroll
        for (int r4 = 0; r4 < 4; ++r4)
#pragma unroll
            for (int k = 0; k < 4; ++k) w[r4][k] = *((const u32x2*)(X3 + (size_t)(m0 + r4) * D) + lane + 64 * k);
#pragma unroll
        for (int r4 = 0; r4 < 4; ++r4) { f32x4 v[4]; float s = 0.f;
#pragma unroll
            for (int k = 0; k < 4; ++k) { v[k] = (f32x4){bflo(w[r4][k].x), bfhi(w[r4][k].x), bflo(w[r4][k].y), bfhi(w[r4][k].y)};
                s += (v[k][0] * v[k][0] + v[k][1] * v[k][1]) + (v[k][2] * v[k][2] + v[k][3] * v[k][3]); }
            const float rs = 1.0f / sqrtf(wave_sum(s) * (1.0f / D) + EPS);
#pragma unroll
            for (int k = 0; k < 4; ++k) __builtin_nontemporal_store(v[k] * rs * gv[k], (f32x4*)(p.out + (size_t)(m0 + r4) * D) + lane + 64 * k); }
    }
}

__global__ void __launch_bounds__(NTHREADS, 2) mega_fwd(Params p) {
    extern __shared__ __attribute__((aligned(16))) unsigned char lds_raw[];
    LAS unsigned char* lds = (LAS unsigned char*)lds_raw;
    cg::grid_group grid = cg::this_grid();
    unsigned char* ws = p.ws;
    const int G = gridDim.x, c = blockIdx.x;
    const int lo = p.ph_lo, hi = p.ph_hi;
#define IN(k) (lo <= (k) && (k) < hi)
    volatile LAS unsigned* xb_st = (volatile LAS unsigned*)(lds + 140 * 1024);
    if (threadIdx.x < 2) xb_st[threadIdx.x] = 0u;
    unsigned* xb_words = (unsigned*)(ws + WS_XBAR);
    if (blockIdx.x == 0) for (int i = threadIdx.x; i < XCD_BAR_WORDS; i += NTHREADS) xb_words[i] = 0u;
    if (blockIdx.x == 0 && threadIdx.x < 8) ((unsigned*)(ws + WS_GQ))[threadIdx.x] = 0u;
    __syncthreads();
    XcdBarrier xbar; xbar.bar = xb_words; xbar.x = 0; xbar.st = xb_st;
#define GRID_BARRIER() xcd_barrier(xbar)
#define SEAM(k) do { if (IN(k) && IN((k) + 1)) { if ((k) == 0) { grid.sync(); xbar = xcd_barrier_post(xb_words, xb_st); } else GRID_BARRIER(); } } while (0)
    if (IN(0)) p0_prep(p, lds);
    SEAM(0);
    if (IN(1)) {
        pg8::Gemm g{(const bf16_t*)(ws + WS_XB), nullptr, (const bf16_t*)(ws + WS_W1IN), nullptr, D, D, D, 1}; pg8::Order S; S.init(T, 2 * DFF, G, c, 1);
        pg8::EpiSwiGLU E{(const float*)(ws + WS_RS0), nullptr, (bf16_t*)(ws + WS_H)};
        pg8::gemm_phase(lds, g, S, E);
    }
    SEAM(1);
    if (IN(2)) {
        pg8::Gemm g{(const bf16_t*)(ws + WS_H), nullptr, (const bf16_t*)(ws + WS_W1OUT), nullptr, DFF, DFF, DFF, 1}; pg8::Order S; S.init(T, D, G, c, 1, true);
        pg8::EpiResid<false, true> E{(const bf16_t*)(ws + WS_XB), 0.5f, nullptr, (bf16_t*)(ws + WS_XB), (float*)(ws + WS_SSQ1)};
        pg8::gemm_phase(lds, g, S, E);
    }
    SEAM(2);
    if (IN(3)) {
        pg8::Gemm g{(const bf16_t*)(ws + WS_XB), nullptr, (const bf16_t*)(ws + WS_WIN), nullptr, D, D, D, 1}; pg8::Order S; S.init(T, NWIN, G, c, 1, false, true);
        pg8::EpiWin E{(const float*)(ws + WS_SSQ1), (bf16_t*)(ws + WS_U), (bf16_t*)(ws + WS_V), (bf16_t*)(ws + WS_Q), (bf16_t*)(ws + WS_K), (bf16_t*)(ws + WS_VB), (bf16_t*)(ws + WS_R), (bf16_t*)p.out, (bf16_t*)(ws + WS_LA),
                      (float*)(ws + WS_LNST), p.in[I_BGATE], p.in[I_BBA]};
        pg8::gemm_phase(lds, g, S, E);
    }
    SEAM(3);
    if (IN(4)) {
        p4_gmlp3(p, lds, (unsigned*)(ws + WS_GQ));
        p4_gla_pass1(p, lds);
        GRID_BARRIER();
        p4_gla_pass2(p, lds);
    }
    SEAM(4);
    if (IN(5)) {
        pg8::Gemm g{(const bf16_t*)(ws + WS_U), (const bf16_t*)(ws + WS_R), (const bf16_t*)(ws + WS_WPA), (const bf16_t*)(ws + WS_WPB), D, D, D, 1}; pg8::Order S; S.init(T, D, G, c, 2);
        pg8::EpiProj E{(const bf16_t*)p.out, (bf16_t*)(ws + WS_V)};
        pg8::gemm_phase(lds, g, S, E);
    }
    SEAM(5);
    if (IN(6)) {
        pg8::Gemm g{(const bf16_t*)(ws + WS_V), nullptr, (const bf16_t*)(ws + WS_WO), nullptr, D, D, D, 1}; pg8::Order S; S.init(T, D, G, c, 1);
        pg8::EpiResid<false, true> E{(const bf16_t*)(ws + WS_XB), 1.0f, nullptr, (bf16_t*)(ws + WS_X2B), (float*)(ws + WS_SSQ2)};
        pg8::gemm_phase(lds, g, S, E);
    }
    SEAM(6);
    if (IN(7)) {
        pg8::Gemm g{(const bf16_t*)(ws + WS_X2B), nullptr, (const bf16_t*)(ws + WS_W2IN), nullptr, D, D, D, 1}; pg8::Order S; S.init(T, 2 * DFF, G, c, 1);
        pg8::EpiSwiGLU E{nullptr, (const float*)(ws + WS_SSQ2), (bf16_t*)(ws + WS_H2)};
        pg8::gemm_phase(lds, g, S, E);
    }
    SEAM(7);
    if (IN(8)) {
        pg8::Gemm g{(const bf16_t*)(ws + WS_H2), nullptr, (const bf16_t*)(ws + WS_W2OUT), nullptr, DFF, DFF, DFF, 1}; pg8::Order S; S.init(T, D, G, c, 1, true);
        pg8::EpiResid<false, true> E{(const bf16_t*)(ws + WS_X2B), 0.5f, nullptr, (bf16_t*)(ws + WS_X2B), nullptr};
        pg8::gemm_phase(lds, g, S, E);
    }
    SEAM(8);
    if (IN(9)) p9_final(p);
#undef IN
#undef SEAM
#undef GRID_BARRIER
}

extern "C" void kernel_launch(void* const* d_in, const int* in_sizes, int n_in, void* d_out, int out_size, void* d_ws, size_t ws_size, hipStream_t stream) {
    static int grid = 0;
    if (grid == 0) {
        int dev = 0, cus = 0, per_cu = 0;
        (void)hipGetDevice(&dev);
        (void)hipDeviceGetAttribute(&cus, hipDeviceAttributeMultiprocessorCount, dev);
        (void)hipFuncSetAttribute((const void*)mega_fwd, hipFuncAttributeMaxDynamicSharedMemorySize, LDS_BYTES);
        (void)hipOccupancyMaxActiveBlocksPerMultiprocessor(&per_cu, (const void*)mega_fwd, NTHREADS, LDS_BYTES);
        if (per_cu < 1) { fprintf(stderr, "kernel_launch: occupancy query says %d blocks/CU\n", per_cu); per_cu = 1; }
        grid = cus;
        if (n_in != 21 || out_size != T * D || ws_size < WS_END) fprintf(stderr, "kernel_launch: unexpected sizes n_in %d out %d ws %zu\n", n_in, out_size, ws_size);
        fprintf(stderr, "kernel_launch: cus %d per_cu %d grid %d ws %zu\n", cus, per_cu, grid, ws_size);
    }
    Params p{};
    for (int i = 0; i < 21; ++i) p.in[i] = (const float*)d_in[i];
    p.out = (float*)d_out; p.ws = (unsigned char*)d_ws; p.ph_lo = 0; p.ph_hi = 10;
    void* args[] = {&p};
    hipError_t e = hipLaunchCooperativeKernel((const void*)mega_fwd, dim3(grid), dim3(NTHREADS), args, LDS_BYTES, stream);
    if (e != hipSuccess) fprintf(stderr, "cooperative launch failed: %s (grid %d)\n", hipGetErrorString(e), grid);
}
```

```cpp
#include <hip/hip_runtime.h>
#include <hip/hip_cooperative_groups.h>
#include <cstdio>
#include <cstdint>
namespace cg = cooperative_groups;

#define LAS __attribute__((address_space(3)))
typedef unsigned short bf16_t;
typedef short bf16x8 __attribute__((ext_vector_type(8)));
typedef float f32x4 __attribute__((ext_vector_type(4)));
typedef float f32x2 __attribute__((ext_vector_type(2)));
typedef unsigned u32x4 __attribute__((ext_vector_type(4)));
typedef unsigned u32x2 __attribute__((ext_vector_type(2)));
typedef float f32x8 __attribute__((ext_vector_type(8)));
typedef float f32x16 __attribute__((ext_vector_type(16)));
typedef __bf16 bf16x8_t __attribute__((ext_vector_type(8)));
typedef __bf16 bf16x2_t __attribute__((ext_vector_type(2)));

constexpr int T = 65536, D = 1024, DFF = 2816, SEQ = 8192;
constexpr int NWIN = 7680;
constexpr float EPS = 1e-6f;
constexpr int NTHREADS = 512;
constexpr int LDS_BYTES = 147456;

constexpr size_t MiB = (size_t)1 << 20;
constexpr size_t WS_GQ = 128;
constexpr size_t WS_XBAR = 64 * 1024;
constexpr size_t WS_RS0 = 1 * MiB;
constexpr size_t WS_SSQ1 = 2 * MiB;
constexpr size_t WS_SSQ2 = 6 * MiB;
constexpr size_t WS_LNST = 10 * MiB;
constexpr size_t WS_W1IN = 20 * MiB, WS_W1OUT = 31 * MiB, WS_WIN = 37 * MiB, WS_WPA = 52 * MiB, WS_WPB = 54 * MiB, WS_WO = 56 * MiB, WS_W2IN = 58 * MiB, WS_W2OUT = 69 * MiB;
constexpr size_t ACT0 = 76 * MiB;
constexpr size_t WS_XB = ACT0;
constexpr size_t WS_H = ACT0 + 128 * MiB;
constexpr size_t WS_U = ACT0 + 128 * MiB;
constexpr size_t WS_V = ACT0 + 256 * MiB;
constexpr size_t WS_Q = ACT0 + 384 * MiB;
constexpr size_t WS_K = ACT0 + 448 * MiB;
constexpr size_t WS_VB = ACT0 + 512 * MiB;
constexpr size_t WS_R = ACT0 + 640 * MiB;
constexpr size_t WS_LA = ACT0 + 768 * MiB;
constexpr size_t WS_X2B = ACT0 + 128 * MiB;
constexpr size_t WS_H2 = ACT0 + 256 * MiB;
constexpr size_t WS_GLAE = ACT0 + 832 * MiB;
constexpr size_t WS_GLAD = ACT0 + 864 * MiB;
constexpr size_t WS_END = ACT0 + 896 * MiB;
static_assert(WS_END <= 1024 * MiB, "ws map");

__device__ __forceinline__ unsigned f2bf(float f) { unsigned u = __builtin_bit_cast(unsigned, f); return (u + 0x7fffu + ((u >> 16) & 1u)) >> 16; }
__device__ __forceinline__ unsigned pk2(float lo, float hi) { return f2bf(lo) | (f2bf(hi) << 16); }
__device__ __forceinline__ float bf2f(unsigned short b) { return __builtin_bit_cast(float, ((unsigned)b) << 16); }
__device__ __forceinline__ float bflo(unsigned w) { return __builtin_bit_cast(float, w << 16); }
__device__ __forceinline__ float bfhi(unsigned w) { return __builtin_bit_cast(float, w & 0xffff0000u); }
__device__ __forceinline__ float wave_sum(float v) {
#pragma unroll
    for (int o = 1; o < 64; o <<= 1) v += __shfl_xor(v, o);
    return v;
}

__device__ __forceinline__ bf16x8 cvt8(f32x8 v) { return __builtin_bit_cast(bf16x8, __builtin_convertvector(v, bf16x8_t)); }
__device__ __forceinline__ unsigned cvt2(float a, float b) { const f32x2 v = {a, b}; return __builtin_bit_cast(unsigned, __builtin_convertvector(v, bf16x2_t)); }

namespace pg8 {
constexpr int BM = 256, BK = 64, HALF = 128, HTB = HALF * BK * 2, STAGE_BYTES = 8 * HTB, NXCD = 8, WGM = 8;
__host__ __device__ __forceinline__ int lds_byte(int r, int c) { const int st = (r >> 4) * 2 + (c >> 5), rr = r & 15, cc = c & 31, ob = rr * 64 + cc * 2; return st * 1024 + (ob ^ (((ob >> 9) & 1) << 5)); }
__host__ __device__ __forceinline__ void stage_rc(int b, int& R, int& C) { const int st = b / 1024, sb = b % 1024, swz = sb ^ (((sb >> 9) & 1) << 5); R = (st >> 1) * 16 + swz / 64; C = (st & 1) * 32 + (swz % 64) / 2; }
__host__ __device__ __forceinline__ int perm32(int rho) { const int n = rho >> 4, i = rho & 15; return 8 * (i >> 2) + 4 * n + (i & 3); }

struct Unit { int pm, pn, seg; };
struct Gemm { const bf16_t *A0, *A1, *B0, *B1; int lda, ldb, K, nsh; int ablk = 0; };
__device__ __forceinline__ const char* a_ptr(const Gemm& g, const Unit& u) { if (g.ablk) return (const char*)g.A0 + (size_t)u.pm * 16 * (g.K / 32) * 1024;
    const bool s = u.seg >= g.nsh; const bf16_t* b = s ? g.A1 : g.A0; const int ks = s ? u.seg - g.nsh : u.seg; return (const char*)(b + (size_t)u.pm * BM * g.lda + ks * g.K); }
__device__ __forceinline__ const char* b_ptr(const Gemm& g, const Unit& u) { const bool s = u.seg >= g.nsh; const bf16_t* b = s ? g.B1 : g.B0; const int ks = s ? u.seg - g.nsh : u.seg; return (const char*)(b + (size_t)u.pn * BM * g.ldb + ks * g.K); }

struct Order {
    int nM, nN, nwg, G, c, nseg, nper, revn, wgm = 8;
    __device__ void init(int M, int N, int G_, int c_, int nseg_, bool rev = false, bool revn_ = false) { nM = M / BM; nN = N / BM; nwg = nM * nN; G = G_; c = c_; nseg = nseg_; nper = rev ? (nwg - c + G - 1) / G : 0; revn = revn_ ? 1 : 0; }
    __device__ bool next(int i, Unit& u) const {
        int ti = i / nseg; u.seg = i - ti * nseg;
        if (nper > 0) { if (ti >= nper) return false; ti = nper - 1 - ti; }
        const long L = (long)ti * G + c; if (L >= nwg) return false;
        int wgid = (int)L; { const int q = nwg / NXCD, r = nwg % NXCD, xcd = wgid % NXCD, off = wgid / NXCD; wgid = (xcd < r ? xcd * (q + 1) : r * (q + 1) + (xcd - r) * q) + off; }
        const int nig = wgm * nN, gid = wgid / nig, fm = gid * wgm, gsz = (nM - fm) < wgm ? (nM - fm) : wgm;
        u.pm = fm + ((wgid % nig) % gsz); u.pn = (wgid % nig) / gsz; if (revn) u.pn = nN - 1 - u.pn; return true;
    }
};

__device__ __forceinline__ unsigned cvt_pk_bf16(float lo, float hi) { unsigned r; asm volatile("v_cvt_pk_bf16_f32 %0, %1, %2" : "=v"(r) : "v"(lo), "v"(hi)); return r; }
__device__ __forceinline__ f32x2 gelu_pk(f32x2 v) {
    const f32x2 av = __builtin_elementwise_abs(v), d = av * 0.2316418882f + 1.0f;
    f32x2 t; t.x = __builtin_amdgcn_rcpf(d.x); t.y = __builtin_amdgcn_rcpf(d.y);
    f32x2 q = t * 0.5307027145f + (-0.7265760135f); q = q * t + 0.7107068705f; q = q * t + (-0.142248368f); q = q * t + 0.127414796f; q = q * t;
    const f32x2 s = (v * v) * (-0.72134752044f);
    f32x2 e; e.x = __builtin_amdgcn_exp2f(s.x); e.y = __builtin_amdgcn_exp2f(s.y);
    return __builtin_elementwise_max(v, (f32x2){0.f, 0.f}) - av * (q * e);
}
__device__ __forceinline__ f32x4 gelu4(f32x4 v) { const f32x2 a = gelu_pk((f32x2){v[0], v[1]}), b = gelu_pk((f32x2){v[2], v[3]}); return (f32x4){a.x, a.y, b.x, b.y}; }
__device__ __forceinline__ f32x4 ex2n4(f32x4 v) { const f32x4 t = v * (-1.4426950408889634f); return (f32x4){__builtin_amdgcn_exp2f(t[0]), __builtin_amdgcn_exp2f(t[1]), __builtin_amdgcn_exp2f(t[2]), __builtin_amdgcn_exp2f(t[3])}; }
__device__ __forceinline__ f32x4 rcp4(f32x4 v) { return (f32x4){__builtin_amdgcn_rcpf(v[0]), __builtin_amdgcn_rcpf(v[1]), __builtin_amdgcn_rcpf(v[2]), __builtin_amdgcn_rcpf(v[3])}; }
__device__ __forceinline__ f32x4 sigm4(f32x4 v) { return rcp4(ex2n4(v) + 1.0f); }
__device__ __forceinline__ f32x4 exp2_4(f32x4 t) { return (f32x4){__builtin_amdgcn_exp2f(t[0]), __builtin_amdgcn_exp2f(t[1]), __builtin_amdgcn_exp2f(t[2]), __builtin_amdgcn_exp2f(t[3])}; }
__device__ __forceinline__ f32x4 silu4(f32x4 v) { return v * sigm4(v); }
__device__ __forceinline__ f32x4 lsig4(f32x4 v) {
    const f32x4 e = ex2n4(__builtin_elementwise_abs(v)) + 1.0f;
    const f32x4 l = {__builtin_amdgcn_logf(e[0]), __builtin_amdgcn_logf(e[1]), __builtin_amdgcn_logf(e[2]), __builtin_amdgcn_logf(e[3])};
    return (__builtin_elementwise_min(v, (f32x4){0.f, 0.f, 0.f, 0.f}) * 1.4426950408889634f - l) * 0.0625f;
}
__device__ __forceinline__ u32x4 pack8(f32x4 v0, f32x4 v1) { u32x4 w; w.x = cvt_pk_bf16(v0[0], v0[1]); w.y = cvt_pk_bf16(v0[2], v0[3]); w.z = cvt_pk_bf16(v1[0], v1[1]); w.w = cvt_pk_bf16(v1[2], v1[3]); return w; }
__device__ __forceinline__ void unpack8(u32x4 w, f32x4& v0, f32x4& v1) { v0 = (f32x4){bflo(w.x), bfhi(w.x), bflo(w.y), bfhi(w.y)}; v1 = (f32x4){bflo(w.z), bfhi(w.z), bflo(w.w), bfhi(w.w)}; }
__device__ __forceinline__ void rows_rs16(const float* ssq, int row0, int fq, float sc, float (&rsv)[2][4]) {
    f32x4 sv[2][4];
#pragma unroll
    for (int ai = 0; ai < 2; ++ai)
#pragma unroll
        for (int m = 0; m < 4; ++m) sv[ai][m] = *(const f32x4*)(ssq + (size_t)(row0 + ai * 128 + m * 16) * 16 + 4 * fq);
#pragma unroll
    for (int ai = 0; ai < 2; ++ai)
#pragma unroll
        for (int m = 0; m < 4; ++m) { float s = (sv[ai][m][0] + sv[ai][m][1]) + (sv[ai][m][2] + sv[ai][m][3]);
            s += __shfl_xor(s, 16); s += __shfl_xor(s, 32);
            rsv[ai][m] = __builtin_amdgcn_rsqf(s * (1.0f / 1024.0f) + EPS) * sc; }
}

__device__ __forceinline__ void rs_table_fill(LAS float* tab, const float* direct, const float* ssq, int pm, int tid) {
    const int row = tid >> 1, half = tid & 1; const size_t grow = (size_t)pm * 256 + row;
    if (direct) { if (half == 0) tab[row] = direct[grow]; }
    else { const f32x4 v0 = *(const f32x4*)(ssq + grow * 16 + 8 * half), v1 = *(const f32x4*)(ssq + grow * 16 + 8 * half + 4);
        float t = ((v0[0] + v0[1]) + (v0[2] + v0[3])) + ((v1[0] + v1[1]) + (v1[2] + v1[3])); t += __shfl_xor(t, 1);
        if (half == 0) tab[row] = __builtin_amdgcn_rsqf(t * (1.0f / 1024.0f) + EPS); }
}

typedef f32x4 Acc[2][2][4][2];

struct EpiSwiGLU {
    const float* rs_direct;
    const float* ssq;
    bf16_t* H;
    __device__ __forceinline__ bool keep(const Unit&) const { return false; }
    static constexpr bool USES_RS = true;
    __device__ __forceinline__ void run_rs(Acc& acc, const Unit& u, int wr, int wc, int fr, int fq, const LAS float* rs_tab) const {
        const int row0 = u.pm * BM + wr * 64 + fr, col0 = u.pn * 128 + wc * 32 + 8 * fq;
        float rsv[2][4];
#pragma unroll
        for (int ai = 0; ai < 2; ++ai)
#pragma unroll
            for (int m = 0; m < 4; ++m) rsv[ai][m] = rs_tab[ai * HALF + wr * 64 + m * 16 + fr];
#pragma unroll
        for (int ai = 0; ai < 2; ++ai)
#pragma unroll
            for (int m = 0; m < 4; ++m) { const int row = row0 + ai * HALF + m * 16;
                const float rs = rsv[ai][m], c1 = rs * (-1.4426950408889634f), c2 = __builtin_amdgcn_rcpf(rs * rs);
                const f32x4 a0 = acc[ai][0][m][0], a1 = acc[ai][0][m][1], b0 = acc[ai][1][m][0], b1 = acc[ai][1][m][1];
                const f32x4 r0 = rcp4(exp2_4(a0 * c1) * c2 + c2), r1 = rcp4(exp2_4(a1 * c1) * c2 + c2);
                *(u32x4*)(H + ((size_t)(row >> 4) * (DFF / 32) + (u.pn * 4 + wc)) * 512 + fr * 32 + 8 * fq) = pack8((a0 * b0) * r0, (a1 * b1) * r1); }
    }
};
__device__ __forceinline__ void line_swap(const u32x4 o0, const u32x4 o1, bool lo, u32x4& A, u32x4& B) {
    u32x4 recv;
#pragma unroll
    for (int e = 0; e < 4; ++e) { const unsigned send = lo ? o1[e] : o0[e]; recv[e] = (unsigned)__builtin_amdgcn_mov_dpp((int)send, 0x128, 0xf, 0xf, true); }
#pragma unroll
    for (int e = 0; e < 4; ++e) { A[e] = lo ? o0[e] : recv[e]; B[e] = lo ? recv[e] : o1[e]; }
}
template <bool OUT_F32, bool OUT_BF16> struct EpiResid {
    static_assert(!OUT_F32 && OUT_BF16, "bf16 output only");
    static constexpr bool USES_RS = false;
    const bf16_t* base; float scale; float* of32; bf16_t* obf; float* ssq;
    __device__ __forceinline__ bool keep(const Unit&) const { return false; }
    __device__ __forceinline__ void operator()(Acc& acc, const Unit& u, int wr, int wc, int fr, int fq) const {
        const int row0 = u.pm * BM + wr * 64 + fr, col0 = u.pn * BM + wc * 64 + 8 * fq;
        u32x4 bw[2][4][2];
#pragma unroll
        for (int ai = 0; ai < 2; ++ai)
#pragma unroll
            for (int m = 0; m < 4; ++m)
#pragma unroll
                for (int bj = 0; bj < 2; ++bj) bw[ai][m][bj] = *(const u32x4*)(base + (size_t)(row0 + ai * HALF + m * 16) * D + col0 + bj * 32);
        const bool lo = fr < 8;
        bf16_t* const st0 = obf + (size_t)(u.pm * BM + wr * 64 + (fr & 7)) * D + u.pn * BM + wc * 64 + 32 * (fr >> 3) + 8 * fq;
#pragma unroll
        for (int ai = 0; ai < 2; ++ai)
#pragma unroll
            for (int m = 0; m < 4; ++m) { const int row = row0 + ai * HALF + m * 16; float q = 0.f; u32x4 o[2];
#pragma unroll
                for (int bj = 0; bj < 2; ++bj) { f32x4 b0, b1; unpack8(bw[ai][m][bj], b0, b1);
                    const f32x4 v0 = b0 + acc[ai][bj][m][0] * scale, v1 = b1 + acc[ai][bj][m][1] * scale;
                    q += (v0[0] * v0[0] + v0[1] * v0[1]) + (v0[2] * v0[2] + v0[3] * v0[3]) + (v1[0] * v1[0] + v1[1] * v1[1]) + (v1[2] * v1[2] + v1[3] * v1[3]);
                    o[bj] = pack8(v0, v1); }
                u32x4 A, B; line_swap(o[0], o[1], lo, A, B);
                bf16_t* const sp = st0 + (size_t)(ai * HALF + m * 16) * D;
                *(u32x4*)sp = A; *(u32x4*)(sp + 8 * D) = B;
                q += __shfl_xor(q, 16); q += __shfl_xor(q, 32);
                if (ssq && fq == 0) ssq[(size_t)row * 16 + 4 * u.pn + wc] = q; }
    }
};
struct EpiWin {
    const float* ssq; bf16_t *U, *V, *Q, *Kb, *VB, *R, *G, *LA; float* lnst; const float *b_gate, *b_alpha;
    __device__ __forceinline__ bool keep(const Unit&) const { return false; }
    static constexpr bool USES_RS = true; static constexpr const float* rs_direct = nullptr;
    template <int KIND, bool STATS, bool NT>
    __device__ __forceinline__ void body(Acc& acc, bf16_t* basep, int ld, int row0, int col0, const float* bias, float sc, int statc, int wr, int fr, int fq, const LAS float* rs_tab) const {
        f32x4 bv[2][2];
        if (KIND >= 3) {
#pragma unroll
            for (int bj = 0; bj < 2; ++bj)
#pragma unroll
                for (int n = 0; n < 2; ++n) { bv[bj][n] = *(const f32x4*)(bias + col0 + bj * (KIND == 3 ? 1024 : HALF) + 4 * n); if (KIND == 3) bv[bj][n] *= -1.4426950408889634f; } }
        float rsv[2][4];
#pragma unroll
        for (int ai = 0; ai < 2; ++ai)
#pragma unroll
            for (int m = 0; m < 4; ++m) rsv[ai][m] = rs_tab[ai * HALF + wr * 64 + m * 16 + fr] * sc;
#pragma unroll
        for (int ai = 0; ai < 2; ++ai)
#pragma unroll
            for (int m = 0; m < 4; ++m) { const int row = row0 + ai * HALF + m * 16; const float rs = rsv[ai][m]; float s1 = 0.f, s2 = 0.f;
                bf16_t* rowp = basep + (size_t)row * ld + col0;
                if (KIND == 3) {
                    const float c1 = rs * (-1.4426950408889634f); f32x4 rho[2], sbv[2];
#pragma unroll
                    for (int n = 0; n < 2; ++n) { const f32x4 da = exp2_4(acc[ai][0][m][n] * c1 + bv[0][n]) + 1.0f;
                        const f32x4 db = exp2_4(__builtin_elementwise_min(acc[ai][1][m][n] * c1 + bv[1][n], (f32x4){100.f, 100.f, 100.f, 100.f})) + 1.0f;
                        rho[n] = db * rcp4(da); sbv[n] = rcp4(db); }
                    bf16_t* const gp = basep + ((size_t)(row >> 4) * 64 + ((col0 - 8 * fq) >> 5)) * 512 + (row & 15) * 32 + 8 * fq;
                    __builtin_nontemporal_store(pack8(rho[0], rho[1]), (u32x4*)gp); __builtin_nontemporal_store(pack8(sbv[0], sbv[1]), (u32x4*)(gp + 32 * 512));
                } else
#pragma unroll
                for (int bj = 0; bj < 2; ++bj) { f32x4 v0, v1; const f32x4 x0 = acc[ai][bj][m][0], x1 = acc[ai][bj][m][1];
                    if (KIND == 2) { const float c1 = rs * (-1.4426950408889634f), c2 = __builtin_amdgcn_rcpf(rs);
                        v0 = x0 * rcp4(exp2_4(x0 * c1) * c2 + c2); v1 = x1 * rcp4(exp2_4(x1 * c1) * c2 + c2); }
                    else { v0 = x0 * rs; v1 = x1 * rs;
                        if (KIND == 4) { v0 = lsig4(v0 + bv[bj][0]); v1 = lsig4(v1 + bv[bj][1]); }
                        if (KIND == 1) { v0 = gelu4(v0); v1 = gelu4(v1); } }
                    if (STATS) { s1 += (v0[0] + v0[1]) + (v0[2] + v0[3]) + (v1[0] + v1[1]) + (v1[2] + v1[3]);
                        s2 += (v0[0] * v0[0] + v0[1] * v0[1]) + (v0[2] * v0[2] + v0[3] * v0[3]) + (v1[0] * v1[0] + v1[1] * v1[1]) + (v1[2] * v1[2] + v1[3] * v1[3]); }
                    if (!NT) *(u32x4*)(rowp + bj * HALF) = pack8(v0, v1); else __builtin_nontemporal_store(pack8(v0, v1), (u32x4*)(rowp + bj * HALF)); }
                if (STATS) { s1 += __shfl_xor(s1, 16); s1 += __shfl_xor(s1, 32); s2 += __shfl_xor(s2, 16); s2 += __shfl_xor(s2, 32);
                    if (fq == 0) *(f32x2*)(lnst + ((size_t)row * 16 + statc) * 2) = (f32x2){s1, s2}; }
                __builtin_amdgcn_sched_barrier(0); }
    }
    __device__ __forceinline__ void run_rs(Acc& acc, const Unit& u, int wr, int wc, int fr, int fq, const LAS float* rs_tab) const {
        const int pn = u.pn, row0 = u.pm * BM + wr * 64 + fr, cw = wc * 32 + 8 * fq;
        if (pn < 4) body<1, false, false>(acc, U, 1024, row0, 256 * pn + cw, nullptr, 1.f, 0, wr, fr, fq, rs_tab);
        else if (pn < 8) body<1, true, false>(acc, V, 1024, row0, 256 * (pn - 4) + cw, nullptr, 1.f, 4 * (pn - 4) + wc, wr, fr, fq, rs_tab);
        else if (pn < 10) body<0, false, true>(acc, Q, 512, row0, 256 * (pn - 8) + cw, nullptr, 0.08838834764831845f, 0, wr, fr, fq, rs_tab);
        else if (pn < 12) body<0, false, true>(acc, Kb, 512, row0, 256 * (pn - 10) + cw, nullptr, 1.f, 0, wr, fr, fq, rs_tab);
        else if (pn < 16) body<0, false, true>(acc, VB, 1024, row0, 256 * (pn - 12) + cw, nullptr, 1.f, 0, wr, fr, fq, rs_tab);
        else if (pn < 20) body<2, false, true>(acc, R, 1024, row0, 256 * (pn - 16) + cw, nullptr, 1.f, 0, wr, fr, fq, rs_tab);
        else if (pn < 28) body<3, false, true>(acc, G, 2048, row0, 128 * (pn - 20) + cw, b_gate, 1.f, 0, wr, fr, fq, rs_tab);
        else body<4, false, true>(acc, LA, 512, row0, 256 * (pn - 28) + cw, b_alpha, 1.f, 0, wr, fr, fq, rs_tab);
    }
};
struct EpiProj {
    static constexpr bool USES_RS = false;
    const bf16_t* G; bf16_t* Mb;
    __device__ __forceinline__ bool keep(const Unit& u) const { return u.seg == 0; }
    __device__ __forceinline__ void operator()(Acc& acc, const Unit& u, int wr, int wc, int fr, int fq) const {
        const int row0 = u.pm * BM + wr * 64 + fr, col0 = u.pn * BM + wc * 32 + 8 * fq;
        if (u.seg == 0) {
            u32x4 gr[2][4][2];
#pragma unroll
            for (int ai = 0; ai < 2; ++ai)
#pragma unroll
                for (int m = 0; m < 4; ++m)
#pragma unroll
                    for (int bj = 0; bj < 2; ++bj) gr[ai][m][bj] = *(const u32x4*)(G + ((size_t)((row0 + ai * HALF + m * 16) >> 4) * 64 + u.pn * 8 + wc + 4 * bj) * 512 + fr * 32 + 8 * fq);
#pragma unroll
            for (int ai = 0; ai < 2; ++ai)
#pragma unroll
                for (int m = 0; m < 4; ++m)
#pragma unroll
                    for (int bj = 0; bj < 2; ++bj) { f32x4 r0, r1; unpack8(gr[ai][m][bj], r0, r1); acc[ai][bj][m][0] *= r0; acc[ai][bj][m][1] *= r1; }
        } else {
            u32x4 gw[2][4][2];
#pragma unroll
            for (int ai = 0; ai < 2; ++ai)
#pragma unroll
                for (int m = 0; m < 4; ++m)
#pragma unroll
                    for (int bj = 0; bj < 2; ++bj) gw[ai][m][bj] = *(const u32x4*)(G + ((size_t)((row0 + ai * HALF + m * 16) >> 4) * 64 + 32 + u.pn * 8 + wc + 4 * bj) * 512 + fr * 32 + 8 * fq);
#pragma unroll
            for (int ai = 0; ai < 2; ++ai)
#pragma unroll
                for (int m = 0; m < 4; ++m)
#pragma unroll
                    for (int bj = 0; bj < 2; ++bj) { f32x4 sb0, sb1; unpack8(gw[ai][m][bj], sb0, sb1);
                        *(u32x4*)(Mb + ((size_t)((row0 + ai * HALF + m * 16) >> 4) * 32 + u.pn * 8 + wc + 4 * bj) * 512 + fr * 32 + 8 * fq) = pack8(acc[ai][bj][m][0] * sb0, acc[ai][bj][m][1] * sb1); }
        }
    }
};

template <class Epi>
__device__ __forceinline__ void gemm_phase(LAS unsigned char* lds, const Gemm g, const Order& S, const Epi& E) {
    const int tid = threadIdx.x, wid = __builtin_amdgcn_readfirstlane(tid >> 6), lane = tid & 63, wr = wid >> 2, wc = wid & 3, fr = lane & 15, fq = lane >> 4;
    const int nt = g.K / BK;
    unsigned voffA[2], voffB[2];
#pragma unroll
    for (int i = 0; i < 2; ++i) { int R, C; stage_rc(tid * 16 + i * 8192, R, C); const int Rb = (R & ~31) + perm32(R & 31);
        voffA[i] = g.ablk ? (unsigned)(((R >> 4) * (g.K / 32) + (C >> 5)) * 1024 + (R & 15) * 64 + (C & 31) * 2) : (unsigned)(R * g.lda + C) * 2u; voffB[i] = (unsigned)(Rb * g.ldb + C) * 2u; }
    const size_t kstep = (size_t)(BK * 2), kstepA = g.ablk ? (size_t)2048 : kstep;
    const size_t hstepA = g.ablk ? (size_t)8 * (g.K / 32) * 1024 : (size_t)HALF * g.lda * 2, hstepB = (size_t)HALF * g.ldb * 2;
    const unsigned ldsw = (unsigned)wid * 1024u;
    const int aoff = lds_byte(wr * 64 + fr, fq * 8), boff = lds_byte(wc * 32 + fr, fq * 8);
#define PG8_SA(b, h) (((b) * 2 + (h)) * HTB)
#define PG8_SB(b, h) ((4 + (b) * 2 + (h)) * HTB)
#define PG8_STAGE(bufoff, gbase, voff) do { _Pragma("unroll") for (int _i = 0; _i < 2; ++_i) \
        __builtin_amdgcn_global_load_lds((const unsigned*)((const char*)(gbase) + (voff)[_i]), (LAS unsigned*)(lds + (bufoff) + ldsw + _i * 8192), 16, 0, 0); } while (0)
#define PG8_LDA(dst, b, h) do { _Pragma("unroll") for (int m = 0; m < 4; ++m) _Pragma("unroll") for (int k = 0; k < 2; ++k) dst[m][k] = *(const LAS bf16x8*)(lds + PG8_SA(b, h) + aoff + m * 2048 + k * 1024); } while (0)
#define PG8_LDB(dst, b, h) do { _Pragma("unroll") for (int n = 0; n < 2; ++n) _Pragma("unroll") for (int k = 0; k < 2; ++k) dst[n][k] = *(const LAS bf16x8*)(lds + PG8_SB(b, h) + boff + n * 2048 + k * 1024); } while (0)
#define PG8_MMA(ai, bj, At, Bt) do { __builtin_amdgcn_s_setprio(1); _Pragma("unroll") for (int m = 0; m < 4; ++m) _Pragma("unroll") for (int n = 0; n < 2; ++n) _Pragma("unroll") for (int k = 0; k < 2; ++k) \
        acc[ai][bj][m][n] = __builtin_amdgcn_mfma_f32_16x16x32_bf16(Bt[n][k], At[m][k], acc[ai][bj][m][n], 0, 0, 0); __builtin_amdgcn_s_setprio(0); } while (0)
#define PG8_WAIT_V(n) asm volatile("s_waitcnt vmcnt(" #n ")" ::: "memory")
#define PG8_WAIT_L(n) asm volatile("s_waitcnt lgkmcnt(" #n ")" ::: "memory")
#define PG8_BAR __builtin_amdgcn_s_barrier()
#define PG8_SCHED __builtin_amdgcn_sched_barrier(0)
    Unit cur, nxt; int ui = 0;
    if (!S.next(0, cur)) return;
    Acc acc;
#pragma unroll
    for (int a = 0; a < 2; ++a)
#pragma unroll
        for (int b = 0; b < 2; ++b)
#pragma unroll
            for (int m = 0; m < 4; ++m)
#pragma unroll
                for (int n = 0; n < 2; ++n) acc[a][b][m][n] = (f32x4){0.f, 0.f, 0.f, 0.f};
    bf16x8 At[4][2], B0[2][2], B1[2][2];
    const char* cA = a_ptr(g, cur); const char* cB = b_ptr(g, cur);
    PG8_STAGE(PG8_SB(0, 0), cB, voffB); PG8_STAGE(PG8_SB(0, 1), cB + hstepB, voffB); PG8_STAGE(PG8_SA(0, 0), cA, voffA); PG8_STAGE(PG8_SA(0, 1), cA + hstepA, voffA);
    if (wr == 1) PG8_BAR;
    PG8_WAIT_V(2); PG8_BAR;
    PG8_STAGE(PG8_SB(1, 0), cB + kstep, voffB); PG8_STAGE(PG8_SA(1, 0), cA + kstepA, voffA); PG8_STAGE(PG8_SB(1, 1), cB + hstepB + kstep, voffB);
    PG8_WAIT_V(6); PG8_BAR;
    int tab_pm = -1, tab_sel = 0;
    for (;;) {
        if constexpr (Epi::USES_RS) { if (cur.pm != tab_pm) { tab_pm = cur.pm; tab_sel ^= 1;
            rs_table_fill((LAS float*)(lds + 131072 + tab_sel * 1024), E.rs_direct, E.ssq, cur.pm, tid); } }
        const bool has_next = S.next(ui + 1, nxt);
        const char* nA = has_next ? a_ptr(g, nxt) : cA; const char* nB = has_next ? b_ptr(g, nxt) : cB;
        asm volatile(".p2align 8\n\ts_nop 0\n\ts_nop 0\n\ts_nop 0\n\ts_nop 0\n\ts_nop 0\n\ts_nop 0\n\ts_nop 0\n\ts_nop 0\n\ts_nop 0\n\ts_nop 0" ::: "memory");
        for (int t = 0; t < nt; t += 2) {
            const bool last = (t == nt - 2);
            const char* a1 = cA + (size_t)(t + 1) * kstepA;
            const char* a2 = last ? nA : cA + (size_t)(t + 2) * kstepA; const char* b2 = last ? nB : cB + (size_t)(t + 2) * kstep;
            const char* a3 = a2 + kstepA; const char* b3 = b2 + kstep;
            PG8_LDB(B0, 0, 0); PG8_LDB(B1, 0, 1); PG8_SCHED; PG8_LDA(At, 0, 0); PG8_STAGE(PG8_SA(1, 1), a1 + hstepA, voffA);
            PG8_WAIT_V(8); PG8_WAIT_L(0); PG8_BAR; PG8_MMA(0, 0, At, B0); PG8_MMA(0, 1, At, B1); PG8_BAR; PG8_SCHED;
            PG8_LDA(At, 0, 1); PG8_STAGE(PG8_SB(0, 0), b2, voffB); PG8_STAGE(PG8_SB(0, 1), b2 + hstepB, voffB); PG8_STAGE(PG8_SA(0, 0), a2, voffA);
            PG8_WAIT_V(8); PG8_WAIT_L(0); PG8_BAR; PG8_MMA(1, 0, At, B0); PG8_MMA(1, 1, At, B1); PG8_BAR; PG8_SCHED;
            PG8_LDB(B0, 1, 0); PG8_LDB(B1, 1, 1); PG8_SCHED; PG8_LDA(At, 1, 0); PG8_STAGE(PG8_SA(0, 1), a2 + hstepA, voffA);
            PG8_WAIT_V(8); PG8_WAIT_L(0); PG8_BAR; PG8_MMA(0, 0, At, B0); PG8_MMA(0, 1, At, B1); PG8_BAR; PG8_SCHED;
            PG8_LDA(At, 1, 1); PG8_STAGE(PG8_SB(1, 0), b3, voffB); PG8_STAGE(PG8_SB(1, 1), b3 + hstepB, voffB); PG8_STAGE(PG8_SA(1, 0), a3, voffA);
            PG8_WAIT_V(8); PG8_WAIT_L(0); PG8_BAR; PG8_MMA(1, 0, At, B0); PG8_MMA(1, 1, At, B1); PG8_BAR; PG8_SCHED;
        }
        if (wr == 0) PG8_BAR;
        if constexpr (Epi::USES_RS) E.run_rs(acc, cur, wr, wc, fr, fq, (const LAS float*)(lds + 131072 + tab_sel * 1024)); else E(acc, cur, wr, wc, fr, fq);
        if (!has_next) break;
        if (!E.keep(cur)) {
#pragma unroll
            for (int a = 0; a < 2; ++a)
#pragma unroll
                for (int b = 0; b < 2; ++b)
#pragma unroll
                    for (int m = 0; m < 4; ++m)
#pragma unroll
                        for (int n = 0; n < 2; ++n) acc[a][b][m][n] = (f32x4){0.f, 0.f, 0.f, 0.f};
        }
        cur = nxt; cA = nA; cB = nB; ++ui;
        if (wr == 1) PG8_BAR;
    }
    PG8_WAIT_V(0);
    PG8_BAR;
#undef PG8_SA
#undef PG8_SB
#undef PG8_STAGE
#undef PG8_LDA
#undef PG8_LDB
#undef PG8_MMA
#undef PG8_WAIT_V
#undef PG8_WAIT_L
#undef PG8_BAR
#undef PG8_SCHED
}
}


#define XB_TMO      128
#define XB_XCNT(j)  (256  + 64 * (j))
#define XB_XSUB(j)  (1280 + 64 * (j))
#define XB_XGEN(j)  (2304 + 64 * (j))
#define XB_TOP      3328
#define XB_TOPGEN   3392
#define XCD_BAR_WORDS 3456
#define XB_SPIN_CAP (1u << 18)
__device__ __forceinline__ unsigned xb_ld(unsigned* p)              { return __hip_atomic_load(p, __ATOMIC_RELAXED, __HIP_MEMORY_SCOPE_AGENT); }
__device__ __forceinline__ unsigned xb_add(unsigned* p, unsigned v) { return __hip_atomic_fetch_add(p, v, __ATOMIC_RELAXED, __HIP_MEMORY_SCOPE_AGENT); }
__device__ __forceinline__ unsigned xb_xcc_id() { return (unsigned)__builtin_amdgcn_s_getreg((3 << 11) | 20) & 0xFu; }
#define XB_SPIN(cond, bar) do { unsigned _sp = 0; while (cond) { __builtin_amdgcn_s_sleep(1); \
    if ((++_sp & 255u) == 0u) { if (xb_ld(&(bar)[XB_TMO])) break; if (_sp > XB_SPIN_CAP) { atomicAdd(&(bar)[XB_TMO], 1u); break; } } } } while (0)
struct XcdBarrier { unsigned* bar; unsigned x; volatile LAS unsigned* st; };
__device__ __forceinline__ void xcd_barrier_complete(unsigned* bar, unsigned x, unsigned& nloc, unsigned& nx) {
    const unsigned G = gridDim.x * gridDim.y * gridDim.z;
    unsigned sum, cnt, mine, sp = 0u;
    for (;;) {
        sum = 0u; cnt = 0u; mine = 0u;
#pragma unroll
        for (unsigned j = 0; j < 16; ++j) { const unsigned c = xb_ld(&bar[XB_XCNT(j)]); sum += c; cnt += (c > 0u) ? 1u : 0u; mine = (j == x) ? c : mine; }
        if (sum == G) break;
        __builtin_amdgcn_s_sleep(1);
        if ((++sp & 255u) == 0u) { if (xb_ld(&bar[XB_TMO])) break; if (sp > XB_SPIN_CAP) { atomicAdd(&bar[XB_TMO], 1u); break; } }
    }
    nloc = mine > 0u ? mine : 1u; nx = cnt > 0u ? cnt : 1u;
}
__device__ __forceinline__ void xcd_census(const XcdBarrier& b, unsigned& rank, bool& uniform) {
    if (threadIdx.x == 0) {
        const unsigned rk = xb_add(&b.bar[XB_XCNT(b.x)], 1u);
        unsigned nloc, nx; xcd_barrier_complete(b.bar, b.x, nloc, nx);
        const unsigned G = gridDim.x * gridDim.y * gridDim.z;
        bool uni = (nx == 8u) && ((G & 7u) == 0u) && (b.x < 8u) && (rk < (G >> 3));
#pragma unroll
        for (unsigned j = 0; j < 16; ++j) { const unsigned c = xb_ld(&b.bar[XB_XCNT(j)]); if (j < 8u ? c != (G >> 3) : c != 0u) uni = false; }
        b.st[0] = nloc; b.st[1] = nx; b.st[2] = rk; b.st[3] = uni ? 1u : 0u;
    }
    __syncthreads();
    rank = b.st[2]; uniform = b.st[3] != 0u;
}
__device__ __forceinline__ void xcd_barrier(const XcdBarrier& b, bool local = false) {
    asm volatile("s_waitcnt vmcnt(0)" ::: "memory");
    __syncthreads();
    if (threadIdx.x == 0) {
        unsigned* bar = b.bar;
        __builtin_amdgcn_s_waitcnt(0);
        unsigned nloc = b.st[0], nx = b.st[1];
        if (nloc == 0u) { xcd_barrier_complete(bar, b.x, nloc, nx); b.st[0] = nloc; b.st[1] = nx; }
        const unsigned old = xb_add(&bar[XB_XSUB(b.x)], 1u);
        const unsigned gen = old / nloc;
        if (old + 1u == (gen + 1u) * nloc && local) {
            __builtin_amdgcn_fence(__ATOMIC_ACQUIRE, "agent");
            xb_add(&bar[XB_XGEN(b.x)], 1u);
            asm volatile("s_waitcnt vmcnt(0)" ::: "memory");
        } else if (old + 1u == (gen + 1u) * nloc) {
            __builtin_amdgcn_fence(__ATOMIC_RELEASE, "agent");
            asm volatile("s_waitcnt vmcnt(0)" ::: "memory");
            const unsigned og = xb_add(&bar[XB_TOP], 1u);
            const unsigned tg = og / nx;
            if (og + 1u == (tg + 1u) * nx) xb_add(&bar[XB_TOPGEN], 1u);
            else XB_SPIN(xb_ld(&bar[XB_TOPGEN]) == tg, bar);
            __builtin_amdgcn_fence(__ATOMIC_ACQUIRE, "agent");
            xb_add(&bar[XB_XGEN(b.x)], 1u);
            asm volatile("s_waitcnt vmcnt(0)" ::: "memory");
        } else {
            XB_SPIN(xb_ld(&bar[XB_XGEN(b.x)]) == gen, bar);
            __builtin_amdgcn_fence(__ATOMIC_ACQUIRE, "agent");
            asm volatile("s_waitcnt vmcnt(0)" ::: "memory");
        }
    }
    __syncthreads();
}

struct Params {
    const float* in[21];
    float* out;
    unsigned char* ws;
    int ph_lo, ph_hi;
};
enum { I_X = 0, I_F1N, I_F1WI, I_F1WO, I_MIXN, I_WIN, I_BGATE, I_ALNG, I_ALNB, I_AWS, I_ABS, I_BWA, I_BBA, I_BHN, I_WPA, I_WPB, I_WO, I_F2N, I_F2WI, I_F2WO, I_FINN };

__device__ __forceinline__ void transpose_item(const float* W, int ldw, int src_col0, const float* gain, bf16_t* WT, int K, int dst_row0, int k0, LAS float* scr, int lane) {
    const int c4 = lane & 7, rr = lane >> 3;
    f32x4 v[8]; float gv[8];
#pragma unroll
    for (int i = 0; i < 8; ++i) { const int kk = rr + 8 * i; v[i] = *(const f32x4*)(W + (size_t)(k0 + kk) * ldw + src_col0 + 4 * c4); gv[i] = gain ? gain[k0 + kk] : 1.0f; }
#pragma unroll
    for (int i = 0; i < 8; ++i) { const int kk = rr + 8 * i; LAS float* d = scr + kk * 33 + 4 * c4; d[0] = v[i][0] * gv[i]; d[1] = v[i][1] * gv[i]; d[2] = v[i][2] * gv[i]; d[3] = v[i][3] * gv[i]; }
    asm volatile("s_waitcnt lgkmcnt(0)" ::: "memory");
    const int c = lane & 7;
#pragma unroll
    for (int j = 0; j < 4; ++j) { const int n = (lane >> 3) + 8 * j; const LAS float* s = scr + (8 * c) * 33 + n;
        u32x4 o; o.x = pk2(s[0 * 33], s[1 * 33]); o.y = pk2(s[2 * 33], s[3 * 33]); o.z = pk2(s[4 * 33], s[5 * 33]); o.w = pk2(s[6 * 33], s[7 * 33]);
        *(u32x4*)(WT + (size_t)(dst_row0 + n) * K + k0 + 8 * c) = o; }
    asm volatile("s_waitcnt lgkmcnt(0)" ::: "memory");
}
__device__ __forceinline__ void transpose_matrix_item(int it, int kind, const float* W, int ldw, int K, int ndst, const float* gain, bf16_t* WT, LAS float* scr, int lane) {
    const int nblk = ndst / 32, kb = it / nblk, nb = it % nblk, n0 = 32 * nb; int src;
    if (kind == 1) { const int pn = nb >> 3, w = nb & 7; src = (w >> 2) * DFF + 128 * pn + 32 * (w & 3); }
    else if (kind == 2) { if (n0 < 5120) src = n0; else { const int loc = n0 - 5120, j = loc >> 8, w = (loc & 255) >> 5; src = 5136 + (w >> 2) * 1024 + 128 * j + 32 * (w & 3); } }
    else if (kind == 3) { const int w = nb & 7; src = (n0 & ~255) + 64 * (w & 3) + 32 * (w >> 2); }
    else src = n0;
    transpose_item(W, ldw, src, gain, WT, K, n0, 64 * kb, scr, lane);
}
__device__ __forceinline__ void p0_prep(const Params& p, LAS unsigned char* lds) {
    const int tid = threadIdx.x, lane = tid & 63, wave = tid >> 6;
    const int gw = blockIdx.x * 8 + wave, NGW = gridDim.x * 8;
    LAS float* scr = (LAS float*)(lds + wave * 16384);
    unsigned char* ws = p.ws;
    constexpr int I_FI = (D / 64) * (2 * DFF / 32), I_FO = (DFF / 64) * (D / 32), I_WI = (D / 64) * (7168 / 32), I_SQ = (D / 64) * (D / 32);
    constexpr int NITEMS = 2 * I_FI + 2 * I_FO + I_WI + 3 * I_SQ;
    for (int it = gw; it < NITEMS; it += NGW) {
        int r = it;
        if (r < I_FI) { transpose_matrix_item(r, 1, p.in[I_F1WI], 2 * DFF, D, 2 * DFF, p.in[I_F1N], (bf16_t*)(ws + WS_W1IN), scr, lane); continue; } r -= I_FI;
        if (r < I_FI) { transpose_matrix_item(r, 1, p.in[I_F2WI], 2 * DFF, D, 2 * DFF, p.in[I_F2N], (bf16_t*)(ws + WS_W2IN), scr, lane); continue; } r -= I_FI;
        if (r < I_FO) { transpose_matrix_item(r, 3, p.in[I_F1WO], D, DFF, D, nullptr, (bf16_t*)(ws + WS_W1OUT), scr, lane); continue; } r -= I_FO;
        if (r < I_FO) { transpose_matrix_item(r, 3, p.in[I_F2WO], D, DFF, D, nullptr, (bf16_t*)(ws + WS_W2OUT), scr, lane); continue; } r -= I_FO;
        if (r < I_WI) { transpose_matrix_item(r, 2, p.in[I_WIN], 7184, D, 7168, p.in[I_MIXN], (bf16_t*)(ws + WS_WIN), scr, lane); continue; } r -= I_WI;
        if (r < I_SQ) { transpose_matrix_item(r, 0, p.in[I_WPA], D, D, D, nullptr, (bf16_t*)(ws + WS_WPA), scr, lane); continue; } r -= I_SQ;
        if (r < I_SQ) { transpose_matrix_item(r, 0, p.in[I_WPB], D, D, D, p.in[I_BHN], (bf16_t*)(ws + WS_WPB), scr, lane); continue; } r -= I_SQ;
        transpose_matrix_item(r, 3, p.in[I_WO], D, D, D, nullptr, (bf16_t*)(ws + WS_WO), scr, lane);
    }
    {
        bf16_t* WT = (bf16_t*)(ws + WS_WIN) + (size_t)7168 * D; const float* W = p.in[I_WIN]; const float* wa = p.in[I_BWA]; const float* gn = p.in[I_MIXN];
        for (int idx = blockIdx.x * NTHREADS + tid; idx < 512 * D; idx += gridDim.x * NTHREADS) { const int n = idx >> 10, k = idx & 1023; float s = 0.f;
#pragma unroll
            for (int r = 0; r < 16; ++r) s += W[(size_t)k * 7184 + 5120 + r] * wa[r * 512 + n];
            WT[idx] = (bf16_t)f2bf(s * gn[k]); }
    }
    {
        const float* x = p.in[I_X]; bf16_t* xb = (bf16_t*)(ws + WS_XB); float* rs0 = (float*)(ws + WS_RS0);
        for (int m0 = gw * 4; m0 < T; m0 += NGW * 4) { f32x4 v[4][4];
#pragma unroll
            for (int q = 0; q < 4; ++q)
#pragma unroll
                for (int j = 0; j < 4; ++j) v[q][j] = *((const f32x4*)(x + (size_t)(m0 + q) * D) + lane + 64 * j);
#pragma unroll
            for (int q = 0; q < 4; ++q) { unsigned long long* o8 = (unsigned long long*)(xb + (size_t)(m0 + q) * D) + lane; float s = 0.f;
#pragma unroll
                for (int j = 0; j < 4; ++j) { const f32x4 t = v[q][j]; s += (t[0] * t[0] + t[1] * t[1]) + (t[2] * t[2] + t[3] * t[3]); o8[64 * j] = (unsigned long long)cvt2(t[0], t[1]) | ((unsigned long long)cvt2(t[2], t[3]) << 32); }
                s = wave_sum(s); if (lane == 0) rs0[m0 + q] = __builtin_amdgcn_rsqf(s * (1.0f / D) + EPS); } }
    }
}

#define LDS_BARRIER() do { asm volatile("s_waitcnt lgkmcnt(0)" ::: "memory"); __builtin_amdgcn_s_barrier(); asm volatile("" ::: "memory"); } while (0)

namespace gla2 {
constexpr int QP = 272, QOP = 264, JP = 144;
constexpr int OFF_QI = 0, OFF_KI = OFF_QI + 64 * QP, OFF_QO = OFF_KI + 64 * QP, OFF_KST = OFF_QO + 64 * QOP, OFF_VT = OFF_KST + 128 * JP, OFF_PL = OFF_VT + 256 * JP,
              OFF_TOT = OFF_PL + 64 * JP, OFF_DEC = OFF_TOT + 4096, OFF_RED = OFF_DEC + 512, OFF_HG = OFF_RED + 2048, END = OFF_HG + 1024;
static_assert(END <= 131072 && OFF_QO % 16 == 0 && OFF_KST % 16 == 0 && OFF_VT % 16 == 0 && OFF_PL % 16 == 0 && OFF_TOT % 16 == 0 && OFF_HG % 16 == 0, "gla2 lds map");
constexpr int NSEG = 8, LSEG = (SEQ / 64) / NSEG, NITEMS = 32 * NSEG;
}
template <bool FULL>
__device__ __forceinline__ void gla_run(const Params& p, LAS unsigned char* lds, int b, int h, int n_begin, int n_end, f32x16 (&X)[4], float& dprod) {
    using namespace gla2;
    const int tid = threadIdx.x, lane = tid & 63, wave = __builtin_amdgcn_readfirstlane(tid >> 6), r = lane & 31, hh = lane >> 5;
    unsigned char* ws = p.ws;
    const bf16_t* Q = (const bf16_t*)(ws + WS_Q); const bf16_t* Kb = (const bf16_t*)(ws + WS_K); const bf16_t* VB = (const bf16_t*)(ws + WS_VB); const bf16_t* LA = (const bf16_t*)(ws + WS_LA);
    bf16_t* R = (bf16_t*)(ws + WS_R);
    constexpr bool full = FULL;
    const int kp = lane, jg = wave;
    const int vp = tid & 127, jq = tid >> 7;
    LDS_BARRIER();
    if (wave >= 4) __builtin_amdgcn_s_setprio(1);
    unsigned qw[8], kw[8], lw[8], vw[16];
    const size_t rowb = (size_t)b * SEQ;
#define GLA_LOAD_QKL(n) do { \
        _Pragma("unroll") for (int jj = 0; jj < 8; ++jj) { const size_t row = rowb + 64 * (n) + 8 * jg + jj; \
            qw[jj] = *(const unsigned*)(Q + row * 512 + h * 128 + 2 * kp); kw[jj] = *(const unsigned*)(Kb + row * 512 + h * 128 + 2 * kp); lw[jj] = *(const unsigned*)(LA + row * 512 + h * 128 + 2 * kp); } } while (0)
#define GLA_LOAD_V(n) do { \
        _Pragma("unroll") for (int jj = 0; jj < 16; ++jj) { const size_t row = rowb + 64 * (n) + 16 * jq + jj; vw[jj] = *(const unsigned*)(VB + row * 1024 + h * 256 + 2 * vp); } } while (0)
    GLA_LOAD_QKL(n_begin); GLA_LOAD_V(n_begin);
    for (int n = n_begin; n < n_end; ++n) {
        f32x2 pre = {0.f, 0.f}, mid = {0.f, 0.f}, last = {0.f, 0.f};
        {
            float run0 = 0.f, run1 = 0.f;
#pragma unroll
            for (int jj = 0; jj < 8; ++jj) { run0 += bflo(lw[jj]); run1 += bfhi(lw[jj]); }
            *(LAS f32x2*)(lds + OFF_TOT + (jg * 128 + 2 * kp) * 4) = (f32x2){run0, run1};
            u32x4 lo0, lo1, hi0, hi1;
#pragma unroll
            for (int m = 0; m < 4; ++m) { lo0[m] = (vw[2 * m] & 0xffffu) | (vw[2 * m + 1] << 16); hi0[m] = (vw[2 * m] >> 16) | (vw[2 * m + 1] & 0xffff0000u);
                                          lo1[m] = (vw[8 + 2 * m] & 0xffffu) | (vw[8 + 2 * m + 1] << 16); hi1[m] = (vw[8 + 2 * m] >> 16) | (vw[8 + 2 * m + 1] & 0xffff0000u); }
            LAS unsigned char* v0 = lds + OFF_VT + (2 * vp) * JP + 2 * (16 * jq); LAS unsigned char* v1 = v0 + JP;
            *(LAS u32x4*)v0 = lo0; *(LAS u32x4*)(v0 + 16) = lo1; *(LAS u32x4*)v1 = hi0; *(LAS u32x4*)(v1 + 16) = hi1;
        }
        LDS_BARRIER();
        {
#pragma unroll
            for (int g = 0; g < 8; ++g) { const f32x2 t = *(const LAS f32x2*)(lds + OFF_TOT + (g * 128 + 2 * kp) * 4); if (g < jg) pre += t; if (g < 4) mid += t; last += t; }
            const float EM0 = __builtin_amdgcn_exp2f(mid.x), EM1 = __builtin_amdgcn_exp2f(mid.y), EL0 = __builtin_amdgcn_exp2f(last.x - mid.x), EL1 = __builtin_amdgcn_exp2f(last.y - mid.y);
            if (jg == 0) *(LAS f32x2*)(lds + OFF_DEC + 2 * kp * 4) = (f32x2){__builtin_amdgcn_exp2f(last.x), __builtin_amdgcn_exp2f(last.y)};
            f32x8 ks0, ks1; float run0 = pre.x - mid.x, run1 = pre.y - mid.y;
#pragma unroll
            for (int jj = 0; jj < 8; ++jj) {
                run0 += bflo(lw[jj]); run1 += bfhi(lw[jj]);
                const float e0 = __builtin_amdgcn_exp2f(run0), e1 = __builtin_amdgcn_exp2f(run1), r0 = __builtin_amdgcn_rcpf(e0), r1 = __builtin_amdgcn_rcpf(e1);
                const float ki0 = bflo(kw[jj]) * r0, ki1 = bfhi(kw[jj]) * r1;
                ks0[jj] = ki0 * EL0; ks1[jj] = ki1 * EL1;
                if (full) { const float qi0 = bflo(qw[jj]) * e0, qi1 = bfhi(qw[jj]) * e1; const int row = 8 * jg + jj;
                    *(LAS unsigned*)(lds + OFF_QI + row * QP + 4 * kp) = cvt2(qi0, qi1);
                    *(LAS unsigned*)(lds + OFF_KI + row * QP + 4 * kp) = cvt2(ki0, ki1);
                    *(LAS unsigned*)(lds + OFF_QO + row * QOP + 4 * kp) = cvt2(qi0 * EM0, qi1 * EM1); }
            }
            *(LAS bf16x8*)(lds + OFF_KST + (2 * kp) * JP + 16 * jg) = cvt8(ks0);
            *(LAS bf16x8*)(lds + OFF_KST + (2 * kp + 1) * JP + 16 * jg) = cvt8(ks1);
        }
        const int nn = (n + 1 < n_end) ? n + 1 : n;
        GLA_LOAD_QKL(nn);
        bf16_t* const rp0 = R + (rowb + 64 * n + r) * 1024 + h * 256 + 32 * wave + 4 * hh;
        LDS_BARRIER();
        if (full) {
#pragma unroll
            for (int tt = 0; tt < 2; ++tt) { const int t = 2 * wave + tt, jt = t >> 2, it = t & 3; f32x4 acc = {0.f, 0.f, 0.f, 0.f};
                if (jt <= it) {
                    bf16x8 A[4], B[4];
#pragma unroll
                    for (int ks = 0; ks < 4; ++ks) { A[ks] = *(const LAS bf16x8*)(lds + OFF_KI + (16 * jt + (lane & 15)) * QP + 2 * (32 * ks + 8 * (lane >> 4)));
                                                     B[ks] = *(const LAS bf16x8*)(lds + OFF_QI + (16 * it + (lane & 15)) * QP + 2 * (32 * ks + 8 * (lane >> 4))); }
#pragma unroll
                    for (int ks = 0; ks < 4; ++ks) acc = __builtin_amdgcn_mfma_f32_16x16x32_bf16(A[ks], B[ks], acc, 0, 0, 0);
                }
                const int i = 16 * it + (lane & 15), j0 = 16 * jt + 4 * (lane >> 4);
                u32x2 o; o.x = cvt2(j0 <= i ? acc[0] : 0.f, j0 + 1 <= i ? acc[1] : 0.f); o.y = cvt2(j0 + 2 <= i ? acc[2] : 0.f, j0 + 3 <= i ? acc[3] : 0.f);
                *(LAS u32x2*)(lds + OFF_PL + i * JP + 2 * j0) = o; }
            LDS_BARRIER();
        }
        if (!FULL && tid < 128) dprod *= *(const LAS float*)(lds + OFF_DEC + tid * 4);
        const LAS unsigned char* vrow = lds + OFF_VT + (32 * wave + r) * JP + 16 * hh;
        bf16x8 vf[4];
#pragma unroll
        for (int ks = 0; ks < 4; ++ks) vf[ks] = *(const LAS bf16x8*)(vrow + 32 * ks);
        f32x16 oT[2];
        if (full) {
#pragma unroll
            for (int it2 = 0; it2 < 2; ++it2)
#pragma unroll
                for (int e = 0; e < 16; ++e) oT[it2][e] = 0.f;
            {
                bf16x8 p0[2], p1[4];
#pragma unroll
                for (int ks = 0; ks < 2; ++ks) p0[ks] = *(const LAS bf16x8*)(lds + OFF_PL + r * JP + 32 * ks + 16 * hh);
#pragma unroll
                for (int ks = 0; ks < 4; ++ks) p1[ks] = *(const LAS bf16x8*)(lds + OFF_PL + (32 + r) * JP + 32 * ks + 16 * hh);
                oT[0] = __builtin_amdgcn_mfma_f32_32x32x16_bf16(vf[0], p0[0], oT[0], 0, 0, 0); oT[1] = __builtin_amdgcn_mfma_f32_32x32x16_bf16(vf[0], p1[0], oT[1], 0, 0, 0);
                oT[0] = __builtin_amdgcn_mfma_f32_32x32x16_bf16(vf[1], p0[1], oT[0], 0, 0, 0); oT[1] = __builtin_amdgcn_mfma_f32_32x32x16_bf16(vf[1], p1[1], oT[1], 0, 0, 0);
                oT[1] = __builtin_amdgcn_mfma_f32_32x32x16_bf16(vf[2], p1[2], oT[1], 0, 0, 0); oT[1] = __builtin_amdgcn_mfma_f32_32x32x16_bf16(vf[3], p1[3], oT[1], 0, 0, 0);
            }
            __builtin_amdgcn_sched_barrier(0);
#pragma unroll
            for (int kh = 0; kh < 2; ++kh) {
                u32x4 bq[2][2][2];
#pragma unroll
                for (int k2 = 0; k2 < 2; ++k2)
#pragma unroll
                    for (int s = 0; s < 2; ++s)
#pragma unroll
                        for (int it2 = 0; it2 < 2; ++it2) { const LAS unsigned char* qp = lds + OFF_QO + (32 * it2 + r) * QOP + 2 * (32 * (2 * kh + k2) + 16 * s + 4 * hh);
                            const u32x2 b0 = *(const LAS u32x2*)qp, b1 = *(const LAS u32x2*)(qp + 16); bq[k2][s][it2] = (u32x4){b0.x, b0.y, b1.x, b1.y}; }
#pragma unroll
                for (int k2 = 0; k2 < 2; ++k2)
#pragma unroll
                    for (int s = 0; s < 2; ++s) { f32x8 xs;
#pragma unroll
                        for (int e = 0; e < 8; ++e) xs[e] = X[2 * kh + k2][8 * s + e];
                        const bf16x8 A = cvt8(xs);
                        oT[0] = __builtin_amdgcn_mfma_f32_32x32x16_bf16(A, __builtin_bit_cast(bf16x8, bq[k2][s][0]), oT[0], 0, 0, 0);
                        oT[1] = __builtin_amdgcn_mfma_f32_32x32x16_bf16(A, __builtin_bit_cast(bf16x8, bq[k2][s][1]), oT[1], 0, 0, 0); }
                __builtin_amdgcn_sched_barrier(0);
            }
        }
        __builtin_amdgcn_sched_barrier(0);
        GLA_LOAD_V(nn);
        __builtin_amdgcn_sched_barrier(0);
#pragma unroll
        for (int kh = 0; kh < 2; ++kh) {
            bf16x8 ka[2][4];
#pragma unroll
            for (int k2 = 0; k2 < 2; ++k2)
#pragma unroll
                for (int ks = 0; ks < 4; ++ks) ka[k2][ks] = *(const LAS bf16x8*)(lds + OFF_KST + (32 * (2 * kh + k2) + r) * JP + 32 * ks + 16 * hh);
#pragma unroll
            for (int k2 = 0; k2 < 2; ++k2)
#pragma unroll
                for (int g4 = 0; g4 < 4; ++g4) { const f32x4 dv = *(const LAS f32x4*)(lds + OFF_DEC + (32 * (2 * kh + k2) + 8 * g4 + 4 * hh) * 4);
#pragma unroll
                    for (int e = 0; e < 4; ++e) X[2 * kh + k2][4 * g4 + e] *= dv[e]; }
#pragma unroll
            for (int ks = 0; ks < 4; ++ks)
#pragma unroll
                for (int k2 = 0; k2 < 2; ++k2) X[2 * kh + k2] = __builtin_amdgcn_mfma_f32_32x32x16_bf16(ka[k2][ks], vf[ks], X[2 * kh + k2], 0, 0, 0);
            __builtin_amdgcn_sched_barrier(0);
        }
        if (full) {
            bf16_t* const rq0 = R + (rowb + 64 * n + (lane >> 2)) * 1024 + h * 256 + 32 * wave + 8 * (lane & 3);
            u32x4 rq[4];
#pragma unroll
            for (int k = 0; k < 4; ++k) rq[k] = *(const u32x4*)(rq0 + (size_t)k * 16 * 1024);
#pragma unroll
            for (int it2 = 0; it2 < 2; ++it2) { float ss = 0.f;
#pragma unroll
                for (int e = 0; e < 16; ++e) ss += oT[it2][e] * oT[it2][e];
                ss += __shfl_xor(ss, 32);
                if (hh == 0) *(LAS float*)(lds + OFF_RED + ((32 * it2 + r) * 8 + wave) * 4) = ss; }
            LDS_BARRIER();
            LAS unsigned char* stg = lds + OFF_VT + (32 * wave) * JP;
#pragma unroll
            for (int it2 = 0; it2 < 2; ++it2) { const f32x4 s0 = *(const LAS f32x4*)(lds + OFF_RED + (32 * it2 + r) * 32), s1 = *(const LAS f32x4*)(lds + OFF_RED + (32 * it2 + r) * 32 + 16);
                const float rs = __builtin_amdgcn_rsqf(((s0[0] + s0[1]) + (s0[2] + s0[3]) + (s1[0] + s1[1]) + (s1[2] + s1[3])) * (1.0f / 256.0f) + EPS);
#pragma unroll
                for (int g4 = 0; g4 < 4; ++g4) { u32x2 o; o.x = cvt2(oT[it2][4 * g4 + 0] * rs, oT[it2][4 * g4 + 1] * rs); o.y = cvt2(oT[it2][4 * g4 + 2] * rs, oT[it2][4 * g4 + 3] * rs);
                    *(LAS u32x2*)(stg + (32 * it2 + r) * 72 + 2 * (8 * g4 + 4 * hh)) = o; } }
            asm volatile("s_waitcnt lgkmcnt(0)" ::: "memory");
#pragma unroll
            for (int k = 0; k < 4; ++k) { const LAS unsigned char* sp = stg + ((lane >> 2) + 16 * k) * 72 + 16 * (lane & 3);
                const u32x2 a = *(const LAS u32x2*)sp, b = *(const LAS u32x2*)(sp + 8); const u32x4 rv = rq[k]; u32x4 o;
                o.x = cvt2(bflo(a.x) * bflo(rv.x), bfhi(a.x) * bfhi(rv.x)); o.y = cvt2(bflo(a.y) * bflo(rv.y), bfhi(a.y) * bfhi(rv.y));
                o.z = cvt2(bflo(b.x) * bflo(rv.z), bfhi(b.x) * bfhi(rv.z)); o.w = cvt2(bflo(b.y) * bflo(rv.w), bfhi(b.y) * bfhi(rv.w));
                *(u32x4*)(rq0 + (size_t)k * 16 * 1024) = o; }
        }
        LDS_BARRIER();
    }
    __builtin_amdgcn_s_setprio(0);
#undef GLA_LOAD_QKL
#undef GLA_LOAD_V
}

namespace gm2 {
constexpr int WP = 272;
constexpr int OFF_WS = 0, OFF_VT = 128 * WP, OFF_MU = 2 * 128 * WP, OFF_RS = OFF_MU + 512, OFF_NXT = OFF_RS + 512;
}
__device__ __forceinline__ void p4_gmlp2(const Params& p, LAS unsigned char* lds, unsigned* ctr) {
    using namespace gm2;
    const int tid = threadIdx.x, lane = tid & 63, wave = __builtin_amdgcn_readfirstlane(tid >> 6), r = lane & 31, hh = lane >> 5;
    unsigned char* ws = p.ws;
    bf16_t* U = (bf16_t*)(ws + WS_U); const bf16_t* V = (const bf16_t*)(ws + WS_V); const float* lnst = (const float*)(ws + WS_LNST);
    const float* lg = p.in[I_ALNG]; const float* lb = p.in[I_ALNB]; const float* Wsg = p.in[I_AWS]; const float* bs = p.in[I_ABS];
    LAS float* mu = (LAS float*)(lds + OFF_MU); LAS float* rstd = (LAS float*)(lds + OFF_RS); LAS int* nxt = (LAS int*)(lds + OFF_NXT);
    const int it = wave >> 1, ct0 = 2 * (wave & 1), cp = lane, jg = wave, tok = tid >> 2, sub = tid & 3;
    for (int gi = 0; gi < 8; ++gi) {
        const int g = (blockIdx.x + gi) & 7;
        LDS_BARRIER();
        if (tid == 0) { const int c0 = (int)atomicAdd(ctr + g, 1u); const int c1 = (int)atomicAdd(ctr + g, 1u); nxt[0] = c0; nxt[1] = c1; }
        LDS_BARRIER();
        int chunk = nxt[0], next = nxt[1];
        if (chunk >= 512) continue;
        for (int e = tid; e < 128 * 64; e += NTHREADS) { const int i = e >> 6, j = 2 * (e & 63); const f32x2 w = *(const f32x2*)(Wsg + (size_t)g * 16384 + i * 128 + j);
            *(LAS unsigned*)(lds + OFF_WS + i * WP + 2 * j) = cvt2(j <= i ? w.x : 0.f, j + 1 <= i ? w.y : 0.f); }
        const f32x2 lgv = *(const f32x2*)(lg + g * 128 + 2 * cp), lbv = *(const f32x2*)(lb + g * 128 + 2 * cp);
        unsigned vw[16]; f32x4 st0, st1;
#define GM_LOAD_RAW(ch) do { const size_t t0_ = (size_t)(ch) * 128; \
            _Pragma("unroll") for (int jj = 0; jj < 16; ++jj) vw[jj] = *(const unsigned*)(V + (t0_ + 16 * jg + jj) * 1024 + g * 128 + 2 * cp); \
            st0 = *(const f32x4*)(lnst + (t0_ + tok) * 32 + sub * 8); st1 = *(const f32x4*)(lnst + (t0_ + tok) * 32 + sub * 8 + 4); } while (0)
        GM_LOAD_RAW(chunk);
        while (chunk < 512) {
            const size_t t0 = (size_t)chunk * 128;
            int next2 = 0; if (tid == 0) next2 = (int)atomicAdd(ctr + g, 1u);
            const int i = 32 * it + r;
            u32x2 uw[2][4];
#pragma unroll
            for (int cc = 0; cc < 2; ++cc)
#pragma unroll
                for (int g4 = 0; g4 < 4; ++g4) uw[cc][g4] = *(const u32x2*)(U + (t0 + i) * 1024 + g * 128 + 32 * (ct0 + cc) + 8 * g4 + 4 * hh);
            const float bsv = bs[g * 128 + i];
            {
                float s1 = (st0[0] + st0[2]) + (st1[0] + st1[2]), s2 = (st0[1] + st0[3]) + (st1[1] + st1[3]);
                s1 += __shfl_xor(s1, 1); s2 += __shfl_xor(s2, 1); s1 += __shfl_xor(s1, 2); s2 += __shfl_xor(s2, 2);
                const float mean = s1 * (1.0f / 1024.0f), var = s2 * (1.0f / 1024.0f) - mean * mean;
                LDS_BARRIER();
                if (sub == 0) { mu[tok] = mean; rstd[tok] = 1.0f / sqrtf(fmaxf(var, 0.f) + EPS); }
            }
            LDS_BARRIER();
            {
                f32x8 a0[2], a1[2];
#pragma unroll
                for (int jj = 0; jj < 16; ++jj) { const float m = mu[16 * jg + jj], rs = rstd[16 * jg + jj];
                    a0[jj >> 3][jj & 7] = (bflo(vw[jj]) - m) * rs * lgv.x + lbv.x; a1[jj >> 3][jj & 7] = (bfhi(vw[jj]) - m) * rs * lgv.y + lbv.y; }
#pragma unroll
                for (int q = 0; q < 2; ++q) { *(LAS bf16x8*)(lds + OFF_VT + (2 * cp) * WP + 2 * (16 * jg + 8 * q)) = cvt8(a0[q]); *(LAS bf16x8*)(lds + OFF_VT + (2 * cp + 1) * WP + 2 * (16 * jg + 8 * q)) = cvt8(a1[q]); }
            }
            { const int nn = next < 512 ? next : 511; GM_LOAD_RAW(nn); }
            LDS_BARRIER();
            f32x16 acc[2];
#pragma unroll
            for (int cc = 0; cc < 2; ++cc)
#pragma unroll
                for (int e = 0; e < 16; ++e) acc[cc][e] = 0.f;
            const int nks = 2 * it + 2;
            for (int ks = 0; ks < nks; ks += 2) {
                bf16x8 B[2], A[2][2];
#pragma unroll
                for (int k2 = 0; k2 < 2; ++k2) { B[k2] = *(const LAS bf16x8*)(lds + OFF_WS + (32 * it + r) * WP + 2 * (16 * (ks + k2) + 8 * hh));
#pragma unroll
                    for (int cc = 0; cc < 2; ++cc) A[k2][cc] = *(const LAS bf16x8*)(lds + OFF_VT + (32 * (ct0 + cc) + r) * WP + 2 * (16 * (ks + k2) + 8 * hh)); }
#pragma unroll
                for (int k2 = 0; k2 < 2; ++k2)
#pragma unroll
                    for (int cc = 0; cc < 2; ++cc) acc[cc] = __builtin_amdgcn_mfma_f32_32x32x16_bf16(A[k2][cc], B[k2], acc[cc], 0, 0, 0);
            }
#pragma unroll
            for (int cc = 0; cc < 2; ++cc)
#pragma unroll
                for (int g4 = 0; g4 < 4; ++g4) { const u32x2 w = uw[cc][g4]; u32x2 o;
                    o.x = cvt2(bflo(w.x) * (acc[cc][4 * g4 + 0] + bsv), bfhi(w.x) * (acc[cc][4 * g4 + 1] + bsv)); o.y = cvt2(bflo(w.y) * (acc[cc][4 * g4 + 2] + bsv), bfhi(w.y) * (acc[cc][4 * g4 + 3] + bsv));
                    *(u32x2*)(U + (t0 + i) * 1024 + g * 128 + 32 * (ct0 + cc) + 8 * g4 + 4 * hh) = o; }
            if (tid == 0) nxt[2] = next2;
            LDS_BARRIER();
            chunk = next; next = nxt[2];
        }
#undef GM_LOAD_RAW
    }
    LDS_BARRIER();
}


namespace gm3 {
constexpr int WP = 272;
constexpr int OFF_WS = 0, OFF_VT0 = 128 * WP, OFF_VT1 = 2 * 128 * WP, OFF_MU = 3 * 128 * WP, OFF_SLOT = OFF_MU + 1024, OFF_OUT = OFF_SLOT + 512;
}
__device__ __forceinline__ void p4_gmlp3(const Params& p, LAS unsigned char* lds, unsigned* ctr0, int vc, bool local) {
    using namespace gm3;
    const int tid = threadIdx.x, lane = tid & 63, wave = __builtin_amdgcn_readfirstlane(tid >> 6), r = lane & 31, hh = lane >> 5;
    unsigned char* ws = p.ws;
    bf16_t* U = (bf16_t*)(ws + WS_U); const bf16_t* V = (const bf16_t*)(ws + WS_V); const float* lnst = (const float*)(ws + WS_LNST);
    const float* lg = p.in[I_ALNG]; const float* lb = p.in[I_ALNB]; const float* Wsg = p.in[I_AWS]; const float* bs = p.in[I_ABS];
    LAS float* muw = (LAS float*)(lds + OFF_MU) + wave * 32;
    LAS int* slot = (LAS int*)(lds + OFF_SLOT);
    const int ct = wave & 3, ita = (wave < 4) ? 0 : 1, itb = 3 - ita;
    const int cp = lane, jg = wave, tsub = lane >> 2, sub = lane & 3;
    if (wave >= 4) __builtin_amdgcn_s_setprio(1);
    const int nbo = local ? 1 : 8;
    for (int bgi = 0; bgi < 8 * nbo; ++bgi) {
        const int bb = ((vc & 7) + (bgi >> 3)) & 7, g = ((vc >> 3) + bgi) & 7;
        unsigned* const ctr = ctr0 + bb * 8 + g;
#define GM_TICKET() ({ const unsigned t_ = atomicAdd(ctr, 1u); (int)(t_ < 64u ? (unsigned)bb * 64u + t_ : 512u); })
        LDS_BARRIER();
        if (tid == 0) { slot[0] = GM_TICKET(); slot[1] = GM_TICKET(); slot[2] = GM_TICKET(); }
        LDS_BARRIER();
        int cur = slot[0], nxc = slot[1], nn2 = slot[2];
        if (cur >= 512) continue;
        for (int e = tid; e < 128 * 64; e += NTHREADS) { const int i = e >> 6, j = 2 * (e & 63); const f32x2 w = *(const f32x2*)(Wsg + (size_t)g * 16384 + i * 128 + j);
            *(LAS unsigned*)(lds + OFF_WS + i * WP + 2 * j) = cvt2(j <= i ? w.x : 0.f, j + 1 <= i ? w.y : 0.f); }
        const f32x2 lgv = *(const f32x2*)(lg + g * 128 + 2 * cp), lbv = *(const f32x2*)(lb + g * 128 + 2 * cp);
        const float bsa = bs[g * 128 + 32 * ita + r], bsb = bs[g * 128 + 32 * itb + r];
        unsigned vw[16]; f32x4 st0, st1;
#define GM_LOAD_RAW(ch) do { const size_t t0_ = (size_t)(ch) * 128; \
            _Pragma("unroll") for (int jj = 0; jj < 16; ++jj) vw[jj] = *(const unsigned*)(V + (t0_ + 16 * jg + jj) * 1024 + g * 128 + 2 * cp); \
            st0 = *(const f32x4*)(lnst + (t0_ + 16 * jg + tsub) * 32 + sub * 8); st1 = *(const f32x4*)(lnst + (t0_ + 16 * jg + tsub) * 32 + sub * 8 + 4); } while (0)
#define GM_LN(vt) do { \
            float s1_ = (st0[0] + st0[2]) + (st1[0] + st1[2]), s2_ = (st0[1] + st0[3]) + (st1[1] + st1[3]); \
            s1_ += __shfl_xor(s1_, 1); s2_ += __shfl_xor(s2_, 1); s1_ += __shfl_xor(s1_, 2); s2_ += __shfl_xor(s2_, 2); \
            const float mean_ = s1_ * (1.0f / 1024.0f), var_ = s2_ * (1.0f / 1024.0f) - mean_ * mean_; \
            if (sub == 0) *(LAS f32x2*)(muw + 2 * tsub) = (f32x2){mean_, __builtin_amdgcn_rsqf(fmaxf(var_, 0.f) + EPS)}; \
            asm volatile("s_waitcnt lgkmcnt(0)" ::: "memory"); \
            f32x8 a0_[2], a1_[2]; \
            _Pragma("unroll") for (int q_ = 0; q_ < 8; ++q_) { const f32x4 mr_ = *(const LAS f32x4*)(muw + 4 * q_); \
                a0_[q_ >> 2][(2 * q_) & 7] = (bflo(vw[2 * q_]) - mr_[0]) * mr_[1] * lgv.x + lbv.x; a1_[q_ >> 2][(2 * q_) & 7] = (bfhi(vw[2 * q_]) - mr_[0]) * mr_[1] * lgv.y + lbv.y; \
                a0_[q_ >> 2][(2 * q_ + 1) & 7] = (bflo(vw[2 * q_ + 1]) - mr_[2]) * mr_[3] * lgv.x + lbv.x; a1_[q_ >> 2][(2 * q_ + 1) & 7] = (bfhi(vw[2 * q_ + 1]) - mr_[2]) * mr_[3] * lgv.y + lbv.y; } \
            _Pragma("unroll") for (int q_ = 0; q_ < 2; ++q_) { *(LAS bf16x8*)((vt) + (2 * cp) * WP + 2 * (16 * jg + 8 * q_)) = cvt8(a0_[q_]); *(LAS bf16x8*)((vt) + (2 * cp + 1) * WP + 2 * (16 * jg + 8 * q_)) = cvt8(a1_[q_]); } \
            asm volatile("s_waitcnt lgkmcnt(0)" ::: "memory"); } while (0)
        GM_LOAD_RAW(cur);
        GM_LN(lds + OFF_VT0);
        { const int c1 = nxc < 512 ? nxc : 511; GM_LOAD_RAW(c1); }
        int tk = 0; if (tid == 0) tk = GM_TICKET();
        int buf = 0;
        while (cur < 512) {
            const size_t t0 = (size_t)cur * 128;
            const int nn = nn2;
            if (tid == 0) slot[buf] = tk;
            LDS_BARRIER();
            nn2 = slot[buf];
            if (tid == 0) tk = GM_TICKET();
            LAS unsigned char* vt = lds + (buf ? OFF_VT1 : OFF_VT0);
            u32x4 uq[4];
#pragma unroll
            for (int k = 0; k < 4; ++k) uq[k] = *(const u32x4*)(U + (t0 + (tid >> 4) + 32 * k) * 1024 + g * 128 + 8 * (tid & 15));
            f32x16 acca, accb;
#pragma unroll
            for (int e = 0; e < 16; ++e) { acca[e] = 0.f; accb[e] = 0.f; }
            for (int ks = 0; ks < 2 * ita + 2; ++ks) { const bf16x8 A = *(const LAS bf16x8*)(vt + (32 * ct + r) * WP + 2 * (16 * ks + 8 * hh));
                const bf16x8 Ba = *(const LAS bf16x8*)(lds + OFF_WS + (32 * ita + r) * WP + 2 * (16 * ks + 8 * hh)), Bb = *(const LAS bf16x8*)(lds + OFF_WS + (32 * itb + r) * WP + 2 * (16 * ks + 8 * hh));
                acca = __builtin_amdgcn_mfma_f32_32x32x16_bf16(A, Ba, acca, 0, 0, 0); accb = __builtin_amdgcn_mfma_f32_32x32x16_bf16(A, Bb, accb, 0, 0, 0); }
            for (int ks = 2 * ita + 2; ks < 2 * itb + 2; ++ks) { const bf16x8 A = *(const LAS bf16x8*)(vt + (32 * ct + r) * WP + 2 * (16 * ks + 8 * hh));
                const bf16x8 Bb = *(const LAS bf16x8*)(lds + OFF_WS + (32 * itb + r) * WP + 2 * (16 * ks + 8 * hh));
                accb = __builtin_amdgcn_mfma_f32_32x32x16_bf16(A, Bb, accb, 0, 0, 0); }
            if (nxc < 512) GM_LN(lds + (buf ? OFF_VT0 : OFF_VT1));
            { const int c2 = nn < 512 ? nn : 511; GM_LOAD_RAW(c2); }
#pragma unroll
            for (int g4 = 0; g4 < 4; ++g4) {
                u32x2 o; o.x = cvt2(acca[4 * g4 + 0] + bsa, acca[4 * g4 + 1] + bsa); o.y = cvt2(acca[4 * g4 + 2] + bsa, acca[4 * g4 + 3] + bsa);
                *(LAS u32x2*)(lds + OFF_OUT + (32 * ita + r) * WP + 2 * (32 * ct + 8 * g4 + 4 * hh)) = o;
                o.x = cvt2(accb[4 * g4 + 0] + bsb, accb[4 * g4 + 1] + bsb); o.y = cvt2(accb[4 * g4 + 2] + bsb, accb[4 * g4 + 3] + bsb);
                *(LAS u32x2*)(lds + OFF_OUT + (32 * itb + r) * WP + 2 * (32 * ct + 8 * g4 + 4 * hh)) = o; }
            LDS_BARRIER();
#pragma unroll
            for (int k = 0; k < 4; ++k) { const u32x4 sp = *(const LAS u32x4*)(lds + OFF_OUT + ((tid >> 4) + 32 * k) * WP + 16 * (tid & 15)); const u32x4 uu = uq[k]; u32x4 o;
                o.x = cvt2(bflo(uu.x) * bflo(sp.x), bfhi(uu.x) * bfhi(sp.x)); o.y = cvt2(bflo(uu.y) * bflo(sp.y), bfhi(uu.y) * bfhi(sp.y));
                o.z = cvt2(bflo(uu.z) * bflo(sp.z), bfhi(uu.z) * bfhi(sp.z)); o.w = cvt2(bflo(uu.w) * bflo(sp.w), bfhi(uu.w) * bfhi(sp.w));
                *(u32x4*)(U + (t0 + (tid >> 4) + 32 * k) * 1024 + g * 128 + 8 * (tid & 15)) = o; }
            cur = nxc; nxc = nn; buf ^= 1;
        }
#undef GM_LOAD_RAW
#undef GM_LN
#undef GM_TICKET
    }
    __builtin_amdgcn_s_setprio(0);
    LDS_BARRIER();
}

__device__ __forceinline__ void p4_gla_pass1(const Params& p, LAS unsigned char* lds, int vc) {
    using namespace gla2;
    const int tid = threadIdx.x, lane = tid & 63, wave = __builtin_amdgcn_readfirstlane(tid >> 6);
    float* E = (float*)(p.ws + WS_GLAE); float* Dg = (float*)(p.ws + WS_GLAD);
    for (int it = vc; it < NITEMS; it += gridDim.x) { const int item = (it & 7) * 32 + (it >> 3);
        const int bh = item / NSEG, seg = item - bh * NSEG; if (seg == NSEG - 1) continue;
        f32x16 X[4];
#pragma unroll
        for (int kt = 0; kt < 4; ++kt)
#pragma unroll
            for (int e = 0; e < 16; ++e) X[kt][e] = 0.f;
        float dprod = 1.f;
        gla_run<false>(p, lds, bh >> 2, bh & 3, seg * LSEG, (seg + 1) * LSEG, X, dprod);
#pragma unroll
        for (int kt = 0; kt < 4; ++kt)
#pragma unroll
            for (int g4 = 0; g4 < 4; ++g4) *(f32x4*)(E + (((((size_t)item * 8 + wave) * 4 + kt) * 4 + g4) * 64 + lane) * 4) = (f32x4){X[kt][4 * g4], X[kt][4 * g4 + 1], X[kt][4 * g4 + 2], X[kt][4 * g4 + 3]};
        if (tid < 128) Dg[item * 128 + tid] = dprod;
    }
}
__device__ __forceinline__ void p4_gla_pass2(const Params& p, LAS unsigned char* lds, int vc) {
    using namespace gla2;
    const int tid = threadIdx.x, lane = tid & 63, wave = __builtin_amdgcn_readfirstlane(tid >> 6), hh = lane >> 5;
    const float* E = (const float*)(p.ws + WS_GLAE); const float* Dg = (const float*)(p.ws + WS_GLAD);
    for (int it = vc; it < NITEMS; it += gridDim.x) { const int item = (it & 7) * 32 + (it >> 3);
        const int bh = item / NSEG, seg = item - bh * NSEG;
        f32x16 X[4];
#pragma unroll
        for (int kt = 0; kt < 4; ++kt)
#pragma unroll
            for (int e = 0; e < 16; ++e) X[kt][e] = 0.f;
        for (int sp = 0; sp < seg; ++sp) { const int it = bh * NSEG + sp;
#pragma unroll
            for (int kt = 0; kt < 4; ++kt)
#pragma unroll
                for (int g4 = 0; g4 < 4; ++g4) { const f32x4 dv = *(const f32x4*)(Dg + it * 128 + 32 * kt + 8 * g4 + 4 * hh);
                    const f32x4 ev = *(const f32x4*)(E + (((((size_t)it * 8 + wave) * 4 + kt) * 4 + g4) * 64 + lane) * 4);
#pragma unroll
                    for (int e = 0; e < 4; ++e) X[kt][4 * g4 + e] = X[kt][4 * g4 + e] * dv[e] + ev[e]; } }
        float dummy = 1.f;
        gla_run<true>(p, lds, bh >> 2, bh & 3, seg * LSEG, (seg + 1) * LSEG, X, dummy);
    }
}

__device__ __forceinline__ void p9_final(const Params& p, int vc) {
    const int tid = threadIdx.x, lane = tid & 63, wave = tid >> 6;
    const int G8 = gridDim.x >> 3;
    const bf16_t* X3 = (const bf16_t*)(p.ws + WS_X2B);
    f32x4 gv[4];
#pragma unroll
    for (int k = 0; k < 4; ++k) gv[k] = *((const f32x4*)(p.in[I_FINN]) + lane + 64 * k);
    const bool g8 = (gridDim.x & 7) == 0;
    const int m_lo = g8 ? (vc & 7) * SEQ + ((vc >> 3) * 8 + wave) * 4 : (vc * 8 + wave) * 4, m_hi = g8 ? ((vc & 7) + 1) * SEQ : T, m_st = g8 ? G8 * 32 : (int)gridDim.x * 32;
    for (int m0 = m_lo; m0 < m_hi; m0 += m_st) {
        u32x2 w[4][4];
#pragma unroll
        for (int r4 = 0; r4 < 4; ++r4)
#pragma unroll
            for (int k = 0; k < 4; ++k) w[r4][k] = *((const u32x2*)(X3 + (size_t)(m0 + r4) * D) + lane + 64 * k);
#pragma unroll
        for (int r4 = 0; r4 < 4; ++r4) { f32x4 v[4]; float s = 0.f;
#pragma unroll
            for (int k = 0; k < 4; ++k) { v[k] = (f32x4){bflo(w[r4][k].x), bfhi(w[r4][k].x), bflo(w[r4][k].y), bfhi(w[r4][k].y)};
                s += (v[k][0] * v[k][0] + v[k][1] * v[k][1]) + (v[k][2] * v[k][2] + v[k][3] * v[k][3]); }
            const float rs = 1.0f / sqrtf(wave_sum(s) * (1.0f / D) + EPS);
#pragma unroll
            for (int k = 0; k < 4; ++k) __builtin_nontemporal_store(v[k] * rs * gv[k], (f32x4*)(p.out + (size_t)(m0 + r4) * D) + lane + 64 * k); }
    }
}

__global__ void __launch_bounds__(NTHREADS, 2) mega_fwd(Params p) {
    extern __shared__ __attribute__((aligned(16))) unsigned char lds_raw[];
    LAS unsigned char* lds = (LAS unsigned char*)lds_raw;
    cg::grid_group grid = cg::this_grid();
    unsigned char* ws = p.ws;
    const int G = gridDim.x;
    const int lo = p.ph_lo, hi = p.ph_hi;
#define IN(k) (lo <= (k) && (k) < hi)
    volatile LAS unsigned* xb_st = (volatile LAS unsigned*)(lds + 140 * 1024);
    if (threadIdx.x < 4) xb_st[threadIdx.x] = 0u;
    unsigned* xb_words = (unsigned*)(ws + WS_XBAR);
    if (blockIdx.x == 0) for (int i = threadIdx.x; i < XCD_BAR_WORDS; i += NTHREADS) xb_words[i] = 0u;
    if (blockIdx.x == 0 && threadIdx.x < 64) ((unsigned*)(ws + WS_GQ))[threadIdx.x] = 0u;
    __syncthreads();
    XcdBarrier xbar; xbar.bar = xb_words; xbar.x = xb_xcc_id(); xbar.st = xb_st;
    bool local = false;
#define GRID_BARRIER() xcd_barrier(xbar, local)
#define SEAM(k) do { if (IN(k) && IN((k) + 1)) xcd_barrier(xbar, local && (k) != 2 && (k) != 6); } while (0)
    if (IN(0)) p0_prep(p, lds);
    grid.sync();
    int c = blockIdx.x;
    { unsigned rank; xcd_census(xbar, rank, local); if (local) c = (int)(rank * 8u + xbar.x); }
    if (IN(1)) {
        pg8::Gemm g{(const bf16_t*)(ws + WS_XB), nullptr, (const bf16_t*)(ws + WS_W1IN), nullptr, D, D, D, 1}; pg8::Order S; S.init(T, 2 * DFF, G, c, 1);
        pg8::EpiSwiGLU E{(const float*)(ws + WS_RS0), nullptr, (bf16_t*)(ws + WS_H)};
        pg8::gemm_phase(lds, g, S, E);
    }
    SEAM(1);
    if (IN(2)) {
        pg8::Gemm g{(const bf16_t*)(ws + WS_H), nullptr, (const bf16_t*)(ws + WS_W1OUT), nullptr, DFF, DFF, DFF, 1, 1}; pg8::Order S; S.init(T, D, G, c, 1, true);
        pg8::EpiResid<false, true> E{(const bf16_t*)(ws + WS_XB), 0.5f, nullptr, (bf16_t*)(ws + WS_XB), (float*)(ws + WS_SSQ1)};
        pg8::gemm_phase(lds, g, S, E);
    }
    SEAM(2);
    if (IN(3)) {
        pg8::Gemm g{(const bf16_t*)(ws + WS_XB), nullptr, (const bf16_t*)(ws + WS_WIN), nullptr, D, D, D, 1}; pg8::Order S; S.init(T, NWIN, G, c, 1, false, true); S.wgm = 4;
        pg8::EpiWin E{(const float*)(ws + WS_SSQ1), (bf16_t*)(ws + WS_U), (bf16_t*)(ws + WS_V), (bf16_t*)(ws + WS_Q), (bf16_t*)(ws + WS_K), (bf16_t*)(ws + WS_VB), (bf16_t*)(ws + WS_R), (bf16_t*)p.out, (bf16_t*)(ws + WS_LA),
                      (float*)(ws + WS_LNST), p.in[I_BGATE], p.in[I_BBA]};
        pg8::gemm_phase(lds, g, S, E);
    }
    SEAM(3);
    if (IN(4)) {
        p4_gmlp3(p, lds, (unsigned*)(ws + WS_GQ), c, local);
        p4_gla_pass1(p, lds, c);
        GRID_BARRIER();
        p4_gla_pass2(p, lds, c);
    }
    SEAM(4);
    if (IN(5)) {
        pg8::Gemm g{(const bf16_t*)(ws + WS_U), (const bf16_t*)(ws + WS_R), (const bf16_t*)(ws + WS_WPA), (const bf16_t*)(ws + WS_WPB), D, D, D, 1}; pg8::Order S; S.init(T, D, G, c, 2);
        pg8::EpiProj E{(const bf16_t*)p.out, (bf16_t*)(ws + WS_V)};
        pg8::gemm_phase(lds, g, S, E);
    }
    SEAM(5);
    if (IN(6)) {
        pg8::Gemm g{(const bf16_t*)(ws + WS_V), nullptr, (const bf16_t*)(ws + WS_WO), nullptr, D, D, D, 1, 1}; pg8::Order S; S.init(T, D, G, c, 1);
        pg8::EpiResid<false, true> E{(const bf16_t*)(ws + WS_XB), 1.0f, nullptr, (bf16_t*)(ws + WS_X2B), (float*)(ws + WS_SSQ2)};
        pg8::gemm_phase(lds, g, S, E);
    }
    SEAM(6);
    if (IN(7)) {
        pg8::Gemm g{(const bf16_t*)(ws + WS_X2B), nullptr, (const bf16_t*)(ws + WS_W2IN), nullptr, D, D, D, 1}; pg8::Order S; S.init(T, 2 * DFF, G, c, 1);
        pg8::EpiSwiGLU E{nullptr, (const float*)(ws + WS_SSQ2), (bf16_t*)(ws + WS_H2)};
        pg8::gemm_phase(lds, g, S, E);
    }
    SEAM(7);
    if (IN(8)) {
        pg8::Gemm g{(const bf16_t*)(ws + WS_H2), nullptr, (const bf16_t*)(ws + WS_W2OUT), nullptr, DFF, DFF, DFF, 1, 1}; pg8::Order S; S.init(T, D, G, c, 1, true);
        pg8::EpiResid<false, true> E{(const bf16_t*)(ws + WS_X2B), 0.5f, nullptr, (bf16_t*)(ws + WS_X2B), nullptr};
        pg8::gemm_phase(lds, g, S, E);
    }
    SEAM(8);
    if (IN(9)) p9_final(p, c);
#undef IN
#undef SEAM
#undef GRID_BARRIER
}

extern "C" void kernel_launch(void* const* d_in, const int* in_sizes, int n_in, void* d_out, int out_size, void* d_ws, size_t ws_size, hipStream_t stream) {
    static int grid = 0;
    if (grid == 0) {
        int dev = 0, cus = 0, per_cu = 0;
        (void)hipGetDevice(&dev);
        (void)hipDeviceGetAttribute(&cus, hipDeviceAttributeMultiprocessorCount, dev);
        (void)hipFuncSetAttribute((const void*)mega_fwd, hipFuncAttributeMaxDynamicSharedMemorySize, LDS_BYTES);
        (void)hipOccupancyMaxActiveBlocksPerMultiprocessor(&per_cu, (const void*)mega_fwd, NTHREADS, LDS_BYTES);
        if (per_cu < 1) { fprintf(stderr, "kernel_launch: occupancy query says %d blocks/CU\n", per_cu); per_cu = 1; }
        grid = cus;
        if (n_in != 21 || out_size != T * D || ws_size < WS_END) fprintf(stderr, "kernel_launch: unexpected sizes n_in %d out %d ws %zu\n", n_in, out_size, ws_size);
        fprintf(stderr, "kernel_launch: cus %d per_cu %d grid %d ws %zu\n", cus, per_cu, grid, ws_size);
    }
    Params p{};
    for (int i = 0; i < 21; ++i) p.in[i] = (const float*)d_in[i];
    p.out = (float*)d_out; p.ws = (unsigned char*)d_ws; p.ph_lo = 0; p.ph_hi = 10;
    void* args[] = {&p};
    hipError_t e = hipLaunchCooperativeKernel((const void*)mega_fwd, dim3(grid), dim3(NTHREADS), args, LDS_BYTES, stream);
    if (e != hipSuccess) fprintf(stderr, "cooperative launch failed: %s (grid %d)\n", hipGetErrorString(e), grid);
}
```
